# Optimizing an MI355X kernel written in HIP

```python
import jax, jax.numpy as jnp
from jax import lax
import numpy as np

D_MODEL = 1024
BATCH = 4
SEQ = 8192
DEPTH = 1

N_HEADS = 8
N_KV_HEADS = 2
HEAD_DIM = 64
ATTN_WIDTH = N_HEADS * HEAD_DIM
CONV_CH = D_MODEL - ATTN_WIDTH
N_IDX_HEADS = 8
IDX_DIM = 64
TOPK_MAX = 256
CONV_K = 31
D_FF = 4 * D_MODEL
ROPE_THETA = 500000.0
Q_BLOCK = 128
EPS = 1e-6
SPLITS = (ATTN_WIDTH, N_KV_HEADS * HEAD_DIM, N_KV_HEADS * HEAD_DIM,
          N_IDX_HEADS * IDX_DIM, IDX_DIM, N_IDX_HEADS, 2 * CONV_CH)
D_IN = ATTN_WIDTH + 4 * N_KV_HEADS * HEAD_DIM // 2 + N_IDX_HEADS * IDX_DIM + IDX_DIM + N_IDX_HEADS + 2 * CONV_CH

kernel_name = "hybrid_dsa_conformer_adaln_layer"


def _rmsnorm(x, g):
    xf = x.astype(jnp.float32)
    y = xf * lax.rsqrt(jnp.mean(xf * xf, axis=-1, keepdims=True) + EPS)
    return (y * g.astype(jnp.float32)).astype(x.dtype)


def _layernorm(x, g, b):
    xf = x.astype(jnp.float32)
    mu = jnp.mean(xf, axis=-1, keepdims=True)
    var = jnp.mean(jnp.square(xf - mu), axis=-1, keepdims=True)
    y = (xf - mu) * lax.rsqrt(var + EPS)
    return (y * g.astype(jnp.float32) + b.astype(jnp.float32)).astype(x.dtype)


def _partial_rope(x, positions):
    d = x.shape[-1]
    rot = d // 4
    half = rot // 2
    inv_freq = jnp.power(ROPE_THETA, -jnp.arange(half, dtype=jnp.float32) * 2.0 / rot)
    ang = positions.astype(jnp.float32)[:, :, None] * inv_freq
    cos = jnp.cos(ang)[:, :, None, :]
    sin = jnp.sin(ang)[:, :, None, :]
    xf = x.astype(jnp.float32)
    x1, x2, rest = xf[..., :half], xf[..., half:rot], xf[..., rot:]
    out = jnp.concatenate([x1 * cos - x2 * sin, x2 * cos + x1 * sin, rest], axis=-1)
    return out.astype(x.dtype)


def _dsa_attention(q, k, v, q_idx, k_idx, w_idx):
    B, S = q.shape[0], q.shape[1]
    nb = S // Q_BLOCK
    topk = min(TOPK_MAX, S // 4)
    groups = N_HEADS // N_KV_HEADS
    key_pos = jnp.arange(S, dtype=jnp.int32)

    def to_blocks(a):
        a = a.reshape((B, nb, Q_BLOCK) + a.shape[2:])
        return jnp.moveaxis(a, 1, 0)

    xs = (to_blocks(q), to_blocks(q_idx), to_blocks(w_idx),
          key_pos.reshape(nb, Q_BLOCK))

    def block_fn(blk):
        qb, qib, wb, tb = blk
        logits = jnp.einsum('bthd,bsd->bths', qib.astype(jnp.float32),
                            k_idx.astype(jnp.float32)) * (IDX_DIM ** -0.5)
        score = jnp.einsum('bth,bths->bts', wb.astype(jnp.float32), jax.nn.relu(logits))
        causal = key_pos[None, :] <= tb[:, None]
        score = jnp.where(causal[None], score, -jnp.inf)
        _, sel = lax.top_k(score, topk)
        sel_ok = sel <= tb[None, :, None]
        k_sel = jax.vmap(lambda kb, ib: kb[ib])(k, sel)
        v_sel = jax.vmap(lambda vb, ib: vb[ib])(v, sel)
        qg = qb.reshape(B, Q_BLOCK, N_KV_HEADS, groups, HEAD_DIM)
        s = jnp.einsum('btkgd,btnkd->btkgn', qg, k_sel).astype(jnp.float32) * (HEAD_DIM ** -0.5)
        s = jnp.where(sel_ok[:, :, None, None, :], s, -jnp.inf)
        p = jax.nn.softmax(s, axis=-1).astype(v.dtype)
        o = jnp.einsum('btkgn,btnkd->btkgd', p, v_sel)
        return o.reshape(B, Q_BLOCK, ATTN_WIDTH)

    out = lax.map(block_fn, xs)
    return jnp.moveaxis(out, 0, 1).reshape(B, S, ATTN_WIDTH)


def _conformer_conv(u, conv_w, conv_b, norm_g, norm_b):
    a, g = jnp.split(u, 2, axis=-1)
    glu = a * jax.nn.sigmoid(g)
    y = lax.conv_general_dilated(
        glu, conv_w[:, None, :], window_strides=(1,),
        padding=[(CONV_K - 1, 0)],
        dimension_numbers=('NWC', 'WIO', 'NWC'),
        feature_group_count=CONV_CH) + conv_b
    y = _layernorm(y, norm_g, norm_b)
    return jax.nn.silu(y)


def setup_inputs(seed: int = 0) -> dict:
    key = jax.random.key(seed)
    ks = jax.random.split(key, 20)
    f32 = jnp.float32
    nrm = lambda k, shp, s: jax.random.normal(k, shp, f32) * s
    x = jax.random.normal(ks[0], (BATCH, SEQ, D_MODEL), f32)
    c = jax.random.normal(ks[1], (BATCH, D_MODEL), f32)
    offset = jax.random.randint(ks[2], (BATCH, 1), 0, 1024, dtype=jnp.int32)
    positions = offset + jnp.arange(SEQ, dtype=jnp.int32)[None, :]
    return {
        "x": x,
        "c": c,
        "positions": positions,
        "w_ada": nrm(ks[3], (DEPTH, D_MODEL, 6 * D_MODEL), 0.5 * D_MODEL ** -0.5),
        "b_ada": nrm(ks[4], (DEPTH, 6 * D_MODEL), 0.01),
        "g_mix": 1.0 + nrm(ks[5], (DEPTH, D_MODEL), 0.02),
        "w_in": nrm(ks[6], (DEPTH, D_MODEL, D_IN), D_MODEL ** -0.5),
        "conv_w": nrm(ks[7], (DEPTH, CONV_K, CONV_CH), CONV_K ** -0.5),
        "conv_b": nrm(ks[8], (DEPTH, CONV_CH), 0.01),
        "conv_norm_g": 1.0 + nrm(ks[9], (DEPTH, CONV_CH), 0.02),
        "conv_norm_b": nrm(ks[10], (DEPTH, CONV_CH), 0.01),
        "w_out": nrm(ks[11], (DEPTH, D_MODEL, D_MODEL), D_MODEL ** -0.5),
        "g_mlp": 1.0 + nrm(ks[12], (DEPTH, D_MODEL), 0.02),
        "w_up": nrm(ks[13], (DEPTH, D_MODEL, D_FF), D_MODEL ** -0.5),
        "w_down": nrm(ks[14], (DEPTH, D_FF, D_MODEL), D_FF ** -0.5),
        "g_final": 1.0 + nrm(ks[15], (D_MODEL,), 0.02),
    }


def reference(x, c, positions, w_ada, b_ada, g_mix, w_in, conv_w, conv_b,
              conv_norm_g, conv_norm_b, w_out, g_mlp, w_up, w_down, g_final):
    B, S, _ = x.shape
    split_at = [int(i) for i in np.cumsum(SPLITS)[:-1]]
    cond = jax.nn.silu(c)
    for i in range(DEPTH):
        mod = jnp.einsum('bd,de->be', cond, w_ada[i]) + b_ada[i]
        sh1, sc1, gt1, sh2, sc2, gt2 = jnp.split(mod, 6, axis=-1)

        h = _rmsnorm(x, g_mix[i]) * (1.0 + sc1[:, None, :]) + sh1[:, None, :]
        proj = jnp.einsum('bsd,de->bse', h, w_in[i])
        q, k, v, qi, ki, wi, cu = jnp.split(proj, split_at, axis=-1)
        q = _partial_rope(q.reshape(B, S, N_HEADS, HEAD_DIM), positions)
        k = _partial_rope(k.reshape(B, S, N_KV_HEADS, HEAD_DIM), positions)
        v = v.reshape(B, S, N_KV_HEADS, HEAD_DIM)
        qi = _partial_rope(qi.reshape(B, S, N_IDX_HEADS, IDX_DIM), positions)
        ki = _partial_rope(ki.reshape(B, S, 1, IDX_DIM), positions)[:, :, 0, :]
        wi = wi * (N_IDX_HEADS ** -0.5)
        attn_out = _dsa_attention(q, k, v, qi, ki, wi)
        conv_out = _conformer_conv(cu, conv_w[i], conv_b[i],
                                   conv_norm_g[i], conv_norm_b[i])
        mixed = jnp.concatenate([attn_out, conv_out], axis=-1)
        x = x + gt1[:, None, :] * jnp.einsum('bse,ed->bsd', mixed, w_out[i])

        h = _rmsnorm(x, g_mlp[i]) * (1.0 + sc2[:, None, :]) + sh2[:, None, :]
        u = jnp.square(jax.nn.relu(jnp.einsum('bsd,df->bsf', h, w_up[i])))
        x = x + gt2[:, None, :] * jnp.einsum('bsf,fd->bsd', u, w_down[i])
    return _rmsnorm(x, g_final)
```

```cpp
#include <cmath>
#include <hip/hip_runtime.h>
#include <cstdio>
#include <cstdint>
namespace pg8 {
#define PG8_LAS __attribute__((address_space(3)))
typedef unsigned short bf16_t;
typedef short bf16x8 __attribute__((ext_vector_type(8)));
typedef float f32x4 __attribute__((ext_vector_type(4)));
typedef unsigned u32x4 __attribute__((ext_vector_type(4)));
constexpr int BM = 256, BK = 64, HALF = 128, HTB = HALF * BK * 2  , STAGE_BYTES = 8 * HTB, NXCD = 8, WGM = 8;

__host__ __device__ __forceinline__ int lds_byte(int r, int c) { const int st = (r >> 4) * 2 + (c >> 5), rr = r & 15, cc = c & 31, ob = rr * 64 + cc * 2; return st * 1024 + (ob ^ (((ob >> 9) & 1) << 5)); }
__host__ __device__ __forceinline__ void stage_rc(int b, int& R, int& C) { const int st = b / 1024, sb = b % 1024, swz = sb ^ (((sb >> 9) & 1) << 5); R = (st >> 1) * 16 + swz / 64; C = (st & 1) * 32 + (swz % 64) / 2; }
__host__ __device__ __forceinline__ int perm32(int rho) { const int n = rho >> 4, i = rho & 15; return 8 * (i >> 2) + 4 * n + (i & 3); }

struct Unit { int pm, pn; };
struct Gemm { const bf16_t* A; const bf16_t* Bt; int M, N, K; };

struct StaticOrder {
    int nM, nN, nwg, G, c;
    __host__ __device__ void init(int M, int N, int G_, int c_) { nM = M / BM; nN = N / BM; nwg = nM * nN; G = G_; c = c_; }
    __host__ __device__ bool next(int i, Unit& u) const {
        const long L = (long)i * G + c; if (L >= nwg) return false;
        int wgid = (int)L; { const int q = nwg / NXCD, r = nwg % NXCD, xcd = wgid % NXCD, off = wgid / NXCD; wgid = (xcd < r ? xcd * (q + 1) : r * (q + 1) + (xcd - r) * q) + off; }
        const int nig = WGM * nN, gid = wgid / nig, fm = gid * WGM, gsz = (nM - fm) < WGM ? (nM - fm) : WGM;
        u.pm = fm + ((wgid % nig) % gsz); u.pn = (wgid % nig) / gsz; return true;
    }
    __device__ __forceinline__ void a_ready(const Unit&) const {}
    __device__ __forceinline__ void done(const Unit&) const {}
};

__device__ __forceinline__ unsigned cvt_pk_bf16(float lo, float hi) { unsigned r; asm volatile("v_cvt_pk_bf16_f32 %0, %1, %2" : "=v"(r) : "v"(lo), "v"(hi)); return r; }
typedef float f32x2 __attribute__((ext_vector_type(2)));
__device__ __forceinline__ f32x2 gelu_pk(f32x2 v) {
    const f32x2 av = __builtin_elementwise_abs(v), d = av * 0.2316418882f + 1.0f;
    f32x2 t; t.x = __builtin_amdgcn_rcpf(d.x); t.y = __builtin_amdgcn_rcpf(d.y);
    f32x2 q = t * 0.5307027145f + (-0.7265760135f); q = q * t + 0.7107068705f; q = q * t + (-0.142248368f); q = q * t + 0.127414796f; q = q * t;
    const f32x2 s = (v * v) * (-0.72134752044f);
    f32x2 e; e.x = __builtin_amdgcn_exp2f(s.x); e.y = __builtin_amdgcn_exp2f(s.y);
    const f32x2 m = v * (q * e), r = v - m;
    f32x2 o; o.x = v.x < 0.f ? m.x : r.x; o.y = v.y < 0.f ? m.y : r.y; return o;
}

template <int ACT  > struct EpiBf16 {
    static constexpr bool PERM = true, AFTER_DRAIN = false; static_assert(ACT == 0 || ACT == 1 || ACT == 2, "EpiBf16: ACT is 0 (none), 1 (gelu_pk) or 2 (squared relu)");
    bf16_t* O; int ldc; const float* bias; int split_cols; size_t split_stride; float scale0;
    __device__ __forceinline__ void operator()(const f32x4 (&acc)[2][2][4][2], const Unit& u, int wr, int wc, int fr, int fq) const {
        const int row0 = u.pm * BM + wr * 64 + fr; int colt = u.pn * BM; bf16_t* base = O;
        float sc = 1.f; if (split_cols) { const int t = colt / split_cols; base += (size_t)t * split_stride; colt -= t * split_cols; if (t == 0) sc = scale0; }
        const int col0 = colt + wc * 32 + 8 * fq, bcol0 = u.pn * BM + wc * 32 + 8 * fq;
        f32x4 bv[2][2];
#pragma unroll
        for (int bj = 0; bj < 2; ++bj)
#pragma unroll
            for (int n = 0; n < 2; ++n) bv[bj][n] = bias ? *(const f32x4*)(bias + bcol0 + bj * HALF + 4 * n) : (f32x4){0.f, 0.f, 0.f, 0.f};
#pragma unroll
        for (int ai = 0; ai < 2; ++ai)
#pragma unroll
            for (int m = 0; m < 4; ++m) { bf16_t* rowp = base + (size_t)(row0 + ai * HALF + m * 16) * ldc + col0;
#pragma unroll
                for (int bj = 0; bj < 2; ++bj) { f32x4 v0 = acc[ai][bj][m][0] + bv[bj][0], v1 = acc[ai][bj][m][1] + bv[bj][1];
                    if (ACT == 1) { f32x2 a = gelu_pk((f32x2){v0[0], v0[1]}), b = gelu_pk((f32x2){v0[2], v0[3]}), c = gelu_pk((f32x2){v1[0], v1[1]}), d = gelu_pk((f32x2){v1[2], v1[3]});
                        v0 = (f32x4){a.x, a.y, b.x, b.y}; v1 = (f32x4){c.x, c.y, d.x, d.y}; }
                    if (ACT == 2) { v0 = __builtin_elementwise_max(v0, (f32x4){0.f, 0.f, 0.f, 0.f}); v1 = __builtin_elementwise_max(v1, (f32x4){0.f, 0.f, 0.f, 0.f}); v0 = v0 * v0; v1 = v1 * v1; }
                    v0 = v0 * sc; v1 = v1 * sc; u32x4 w; w.x = cvt_pk_bf16(v0[0], v0[1]); w.y = cvt_pk_bf16(v0[2], v0[3]); w.z = cvt_pk_bf16(v1[0], v1[1]); w.w = cvt_pk_bf16(v1[2], v1[3]);
                    *(u32x4*)(rowp + bj * HALF) = w; } }
    }
};


struct EpiResGate {
    static constexpr bool PERM = false, AFTER_DRAIN = false;
    const float* base; float* out; int ldc; const float* gate; int gate_stride; int rows_per_batch;
    __device__ __forceinline__ void operator()(const f32x4 (&acc)[2][2][4][2], const Unit& u, int wr, int wc, int fr, int fq) const {
        const int row0 = u.pm * BM + wr * 64 + fr, col0 = u.pn * BM + wc * 32 + 4 * fq;
        const float* gp = gate + (size_t)((u.pm * BM) / rows_per_batch) * gate_stride + col0;
        f32x4 gv[2][2];
#pragma unroll
        for (int bj = 0; bj < 2; ++bj)
#pragma unroll
            for (int n = 0; n < 2; ++n) gv[bj][n] = *(const f32x4*)(gp + bj * HALF + n * 16);
#pragma unroll
        for (int ai = 0; ai < 2; ++ai)
#pragma unroll
            for (int m = 0; m < 4; ++m) { const size_t off = (size_t)(row0 + ai * HALF + m * 16) * ldc + col0;
#pragma unroll
                for (int bj = 0; bj < 2; ++bj)
#pragma unroll
                    for (int n = 0; n < 2; ++n) { const f32x4 bs = *(const f32x4*)(base + off + bj * HALF + n * 16); *(f32x4*)(out + off + bj * HALF + n * 16) = bs + gv[bj][n] * acc[ai][bj][m][n]; }
                if (m & 1) asm volatile("" ::: "memory"); }
    }
};

template <class Epi, class Sched, bool ALIGN_EPI = false, bool SP2 = false>
__device__ __forceinline__ void gemm_phase(PG8_LAS unsigned char* lds, const Gemm g, const Sched& S, const Epi& E) {
    const int tid = threadIdx.x, wid = __builtin_amdgcn_readfirstlane(tid >> 6), lane = tid & 63, wr = wid >> 2, wc = wid & 3, fr = lane & 15, fq = lane >> 4;
    const int K = g.K, nt = K / BK;
    unsigned voffA[2], voffB[2];
#pragma unroll
    for (int i = 0; i < 2; ++i) { int R, C; stage_rc(tid * 16 + i * 8192, R, C); const int Rb = Epi::PERM ? ((R & ~31) + perm32(R & 31)) : R;
        voffA[i] = (unsigned)(R * K + C) * 2u; voffB[i] = (unsigned)(Rb * K + C) * 2u; }
    const size_t kstep = (size_t)(BK * 2);
    const size_t hstep = (size_t)HALF * K * 2;
    const size_t tstep = 2 * hstep;
    const unsigned ldsw = (unsigned)wid * 1024u;
    const int aoff = lds_byte(wr * 64 + fr, fq * 8), boff = lds_byte(wc * 32 + fr, fq * 8);
#define PG8_SA(b, h) (((b) * 2 + (h)) * HTB)
#define PG8_SB(b, h) ((4 + (b) * 2 + (h)) * HTB)
#define PG8_STAGE(bufoff, gbase, voff) do { _Pragma("unroll") for (int _i = 0; _i < 2; ++_i) \
        __builtin_amdgcn_global_load_lds((const unsigned*)((const char*)(gbase) + (voff)[_i]), (PG8_LAS unsigned*)(lds + (bufoff) + ldsw + _i * 8192), 16, 0, 0); } while (0)
#define PG8_LDA(dst, b, h) do { _Pragma("unroll") for (int m = 0; m < 4; ++m) _Pragma("unroll") for (int k = 0; k < 2; ++k) dst[m][k] = *(const PG8_LAS bf16x8*)(lds + PG8_SA(b, h) + aoff + m * 2048 + k * 1024); } while (0)
#define PG8_LDB(dst, b, h) do { _Pragma("unroll") for (int n = 0; n < 2; ++n) _Pragma("unroll") for (int k = 0; k < 2; ++k) dst[n][k] = *(const PG8_LAS bf16x8*)(lds + PG8_SB(b, h) + boff + n * 2048 + k * 1024); } while (0)
#define PG8_MMA(ai, bj, At, Bt) do { __builtin_amdgcn_s_setprio(1); _Pragma("unroll") for (int m = 0; m < 4; ++m) _Pragma("unroll") for (int n = 0; n < 2; ++n) _Pragma("unroll") for (int k = 0; k < 2; ++k) \
        acc[ai][bj][m][n] = __builtin_amdgcn_mfma_f32_16x16x32_bf16(Bt[n][k], At[m][k], acc[ai][bj][m][n], 0, 0, 0); __builtin_amdgcn_s_setprio(0); } while (0)
#define PG8_WAIT_V(n) asm volatile("s_waitcnt vmcnt(" #n ")" ::: "memory")
#define PG8_WAIT_L(n) asm volatile("s_waitcnt lgkmcnt(" #n ")" ::: "memory")
#define PG8_BAR __builtin_amdgcn_s_barrier()
#define PG8_SCHED __builtin_amdgcn_sched_barrier(0)
    Unit cur, nxt; int ui = 0;
    if (!S.next(0, cur)) return;
    f32x4 acc[2][2][4][2];
#pragma unroll
    for (int a = 0; a < 2; ++a)
#pragma unroll
        for (int b = 0; b < 2; ++b)
#pragma unroll
            for (int m = 0; m < 4; ++m)
#pragma unroll
                for (int n = 0; n < 2; ++n) acc[a][b][m][n] = (f32x4){0.f, 0.f, 0.f, 0.f};
    bf16x8 At[4][2], B0[2][2], B1[2][2];
    const char* cA = (const char*)g.A + (size_t)cur.pm * tstep; const char* cB = (const char*)g.Bt + (size_t)cur.pn * tstep;
    S.a_ready(cur);
    if constexpr (SP2) {
        PG8_STAGE(PG8_SB(0, 0), cB, voffB); PG8_STAGE(PG8_SB(0, 1), cB + hstep, voffB); PG8_STAGE(PG8_SA(0, 0), cA, voffA); PG8_STAGE(PG8_SA(0, 1), cA + hstep, voffA);
        if (wr == 1) PG8_BAR;
        PG8_WAIT_V(2); PG8_BAR;
        PG8_STAGE(PG8_SB(1, 0), cB + kstep, voffB); PG8_STAGE(PG8_SA(1, 0), cA + kstep, voffA); PG8_STAGE(PG8_SB(1, 1), cB + hstep + kstep, voffB);
        PG8_WAIT_V(6); PG8_BAR;
    } else {
        PG8_STAGE(PG8_SB(0, 0), cB, voffB); PG8_STAGE(PG8_SA(0, 0), cA, voffA); PG8_STAGE(PG8_SB(0, 1), cB + hstep, voffB); PG8_STAGE(PG8_SA(0, 1), cA + hstep, voffA);
        if (wr == 1) PG8_BAR;
        PG8_WAIT_V(4); PG8_BAR;
        PG8_STAGE(PG8_SB(1, 0), cB + kstep, voffB); PG8_STAGE(PG8_SA(1, 0), cA + kstep, voffA); PG8_STAGE(PG8_SB(1, 1), cB + hstep + kstep, voffB);
        PG8_WAIT_V(6); PG8_BAR;
    }
    for (;;) {
        const bool has_next = S.next(ui + 1, nxt);
        const char* nA = has_next ? (const char*)g.A + (size_t)nxt.pm * tstep : cA; const char* nB = has_next ? (const char*)g.Bt + (size_t)nxt.pn * tstep : cB;
        for (int t = 0; t < nt; t += 2) {
            const bool last = (t == nt - 2);
            const char* a1 = cA + (size_t)(t + 1) * kstep;
            const char* a2 = last ? nA : cA + (size_t)(t + 2) * kstep; const char* b2 = last ? nB : cB + (size_t)(t + 2) * kstep;
            const char* a3 = a2 + kstep; const char* b3 = b2 + kstep;
            if (last && has_next) S.a_ready(nxt);
            if constexpr (SP2) {
            PG8_LDB(B0, 0, 0); PG8_LDB(B1, 0, 1); PG8_SCHED; PG8_LDA(At, 0, 0); PG8_STAGE(PG8_SA(1, 1), a1 + hstep, voffA);
            PG8_WAIT_V(8); PG8_WAIT_L(0); PG8_BAR; PG8_MMA(0, 0, At, B0); PG8_MMA(0, 1, At, B1); PG8_BAR; PG8_SCHED;
            PG8_LDA(At, 0, 1); PG8_STAGE(PG8_SB(0, 0), b2, voffB); PG8_STAGE(PG8_SB(0, 1), b2 + hstep, voffB); PG8_STAGE(PG8_SA(0, 0), a2, voffA);
            PG8_WAIT_V(8); PG8_WAIT_L(0); PG8_BAR; PG8_MMA(1, 0, At, B0); PG8_MMA(1, 1, At, B1); PG8_BAR; PG8_SCHED;
            PG8_LDB(B0, 1, 0); PG8_LDB(B1, 1, 1); PG8_SCHED; PG8_LDA(At, 1, 0); PG8_STAGE(PG8_SA(0, 1), a2 + hstep, voffA);
            PG8_WAIT_V(8); PG8_WAIT_L(0); PG8_BAR; PG8_MMA(0, 0, At, B0); PG8_MMA(0, 1, At, B1); PG8_BAR; PG8_SCHED;
            PG8_LDA(At, 1, 1); PG8_STAGE(PG8_SB(1, 0), b3, voffB); PG8_STAGE(PG8_SB(1, 1), b3 + hstep, voffB); PG8_STAGE(PG8_SA(1, 0), a3, voffA);
            PG8_WAIT_V(8); PG8_WAIT_L(0); PG8_BAR; PG8_MMA(1, 0, At, B0); PG8_MMA(1, 1, At, B1); PG8_BAR; PG8_SCHED;
            } else {
            PG8_LDB(B0, 0, 0); PG8_SCHED; PG8_LDA(At, 0, 0); PG8_STAGE(PG8_SA(1, 1), a1 + hstep, voffA);
            PG8_WAIT_L(8); PG8_BAR; PG8_WAIT_L(0); PG8_MMA(0, 0, At, B0); PG8_BAR; PG8_SCHED;
            PG8_LDB(B1, 0, 1); PG8_STAGE(PG8_SB(0, 0), b2, voffB);
            PG8_BAR; PG8_WAIT_L(0); PG8_MMA(0, 1, At, B1); PG8_BAR;
            PG8_LDA(At, 0, 1); PG8_STAGE(PG8_SA(0, 0), a2, voffA);
            PG8_BAR; PG8_WAIT_L(0); PG8_MMA(1, 0, At, B0); PG8_BAR; PG8_SCHED;
            PG8_STAGE(PG8_SB(0, 1), b2 + hstep, voffB);
            PG8_WAIT_V(6); PG8_BAR; PG8_MMA(1, 1, At, B1); PG8_BAR;
            PG8_LDB(B0, 1, 0); PG8_SCHED; PG8_LDA(At, 1, 0); PG8_STAGE(PG8_SA(0, 1), a2 + hstep, voffA);
            PG8_WAIT_L(8); PG8_BAR; PG8_WAIT_L(0); PG8_MMA(0, 0, At, B0); PG8_BAR; PG8_SCHED;
            PG8_LDB(B1, 1, 1); PG8_STAGE(PG8_SB(1, 0), b3, voffB);
            PG8_BAR; PG8_WAIT_L(0); PG8_MMA(0, 1, At, B1); PG8_BAR;
            PG8_LDA(At, 1, 1); PG8_STAGE(PG8_SA(1, 0), a3, voffA);
            PG8_BAR; PG8_WAIT_L(0); PG8_MMA(1, 0, At, B0); PG8_BAR; PG8_SCHED;
            PG8_STAGE(PG8_SB(1, 1), b3 + hstep, voffB);
            PG8_WAIT_V(6); PG8_BAR; PG8_MMA(1, 1, At, B1); PG8_BAR;
            }
        }
        if constexpr (ALIGN_EPI) { if (wr == 0) PG8_BAR; }
        if constexpr (!Epi::AFTER_DRAIN) { E(acc, cur, wr, wc, fr, fq); S.done(cur); }
        if (!has_next) break;
#pragma unroll
        for (int a = 0; a < 2; ++a)
#pragma unroll
            for (int b = 0; b < 2; ++b)
#pragma unroll
                for (int m = 0; m < 4; ++m)
#pragma unroll
                    for (int n = 0; n < 2; ++n) acc[a][b][m][n] = (f32x4){0.f, 0.f, 0.f, 0.f};
        cur = nxt; cA = nA; cB = nB; ++ui;
        if constexpr (ALIGN_EPI) { if (wr == 1) PG8_BAR; }
    }
    PG8_WAIT_V(0);
    if constexpr (!ALIGN_EPI) { if (wr == 0) PG8_BAR; }
    PG8_BAR;
    if constexpr (Epi::AFTER_DRAIN) { E.fused(acc, cur, wr, wc, fr, fq, lds, wid, lane); S.done(cur); }
#undef PG8_SA
#undef PG8_SB
#undef PG8_STAGE
#undef PG8_LDA
#undef PG8_LDB
#undef PG8_MMA
#undef PG8_WAIT_V
#undef PG8_WAIT_L
#undef PG8_BAR
#undef PG8_SCHED
}
}

#ifndef PG8_SP2
#define PG8_SP2 true
#endif
#ifndef PG8_ALIGN
#define PG8_ALIGN true
#endif
#define GAS __attribute__((address_space(1)))
#define LAS __attribute__((address_space(3)))
typedef unsigned short bf16;
typedef unsigned v4u __attribute__((ext_vector_type(4)));
typedef float f32x4 __attribute__((ext_vector_type(4)));
typedef short bf16x8 __attribute__((ext_vector_type(8)));
typedef GAS unsigned gu32;
typedef GAS unsigned long long gu64;
#define RLX_AGENT __ATOMIC_RELAXED, __HIP_MEMORY_SCOPE_AGENT
#define LDS_WAIT() asm volatile("s_waitcnt lgkmcnt(0)" ::: "memory")
#define VM_WAIT() asm volatile("s_waitcnt vmcnt(0)" ::: "memory")
__device__ __forceinline__ unsigned long long rt() { return __builtin_amdgcn_s_memrealtime(); }
__device__ __forceinline__ unsigned f2bf(float f) { unsigned u = __builtin_bit_cast(unsigned, f); return (u + 0x7fffu + ((u >> 16) & 1u)) >> 16; }
__device__ __forceinline__ unsigned pk2(float lo, float hi) { return f2bf(lo) | (f2bf(hi) << 16); }

#define XB_TMO      128
#define XB_XCNT(j)  (256  + 64 * (j))
#define XB_XSUB(j)  (1280 + 64 * (j))
#define XB_XGEN(j)  (2304 + 64 * (j))
#define XB_TOP      3328
#define XB_TOPGEN   3392
#define XCD_BAR_WORDS 3456
#define XB_SPIN_CAP (1u << 22)

__device__ __forceinline__ unsigned xb_ld(unsigned* p)              { return __hip_atomic_load(p, __ATOMIC_RELAXED, __HIP_MEMORY_SCOPE_AGENT); }
__device__ __forceinline__ unsigned xb_add(unsigned* p, unsigned v) { return __hip_atomic_fetch_add(p, v, __ATOMIC_RELAXED, __HIP_MEMORY_SCOPE_AGENT); }
__device__ __forceinline__ unsigned xb_xcc_id() { return (unsigned)__builtin_amdgcn_s_getreg((3 << 11) | 20) & 0xFu; }
#define XB_SPIN(cond, bar) do { unsigned _sp = 0; while (cond) { __builtin_amdgcn_s_sleep(1); \
    if ((++_sp & 255u) == 0u) { if (xb_ld(&(bar)[XB_TMO])) break; if (_sp > XB_SPIN_CAP) { atomicAdd(&(bar)[XB_TMO], 1u); break; } } } } while (0)

struct XcdBarrier {
    unsigned* bar; unsigned x;
    volatile LAS unsigned* st;
};

__device__ __forceinline__ XcdBarrier xcd_barrier_post(unsigned* bar, volatile LAS unsigned* st) {
    XcdBarrier b; b.bar = bar; b.x = xb_xcc_id(); b.st = st;
    if (threadIdx.x == 0) (void)xb_add(&bar[XB_XCNT(b.x)], 1u);
    return b;
}
__device__ __forceinline__ void xcd_barrier_complete(unsigned* bar, unsigned x, unsigned& nloc, unsigned& nx) {
    const unsigned G = gridDim.x * gridDim.y * gridDim.z;
    unsigned sum, cnt, mine, sp = 0u;
    for (;;) {
        sum = 0u; cnt = 0u; mine = 0u;
#pragma unroll
        for (unsigned j = 0; j < 16; ++j) { const unsigned c = xb_ld(&bar[XB_XCNT(j)]); sum += c; cnt += (c > 0u) ? 1u : 0u; mine = (j == x) ? c : mine; }
        if (sum == G) break;
        __builtin_amdgcn_s_sleep(1);
        if ((++sp & 255u) == 0u) { if (xb_ld(&bar[XB_TMO])) break; if (sp > XB_SPIN_CAP) { atomicAdd(&bar[XB_TMO], 1u); break; } }
    }
    nloc = mine > 0u ? mine : 1u; nx = cnt > 0u ? cnt : 1u;
}

__device__ __forceinline__ void xcd_barrier(const XcdBarrier& b) {
    asm volatile("s_waitcnt vmcnt(0)" ::: "memory");
    __syncthreads();
    if (threadIdx.x == 0) {
        unsigned* bar = b.bar;
        __builtin_amdgcn_s_waitcnt(0);
        unsigned nloc = b.st[0], nx = b.st[1];
        if (nloc == 0u) { xcd_barrier_complete(bar, b.x, nloc, nx); b.st[0] = nloc; b.st[1] = nx; }
        const unsigned old = xb_add(&bar[XB_XSUB(b.x)], 1u);
        const unsigned gen = old / nloc;
        if (old + 1u == (gen + 1u) * nloc) {
            __builtin_amdgcn_fence(__ATOMIC_RELEASE, "agent");
            asm volatile("s_waitcnt vmcnt(0)" ::: "memory");
            const unsigned og = xb_add(&bar[XB_TOP], 1u);
            const unsigned tg = og / nx;
            if (og + 1u == (tg + 1u) * nx) xb_add(&bar[XB_TOPGEN], 1u);
            else XB_SPIN(xb_ld(&bar[XB_TOPGEN]) == tg, bar);
            __builtin_amdgcn_fence(__ATOMIC_ACQUIRE, "agent");
            xb_add(&bar[XB_XGEN(b.x)], 1u);
            asm volatile("s_waitcnt vmcnt(0)" ::: "memory");
        } else {
            XB_SPIN(xb_ld(&bar[XB_XGEN(b.x)]) == gen, bar);
            __builtin_amdgcn_fence(__ATOMIC_ACQUIRE, "agent");
            asm volatile("s_waitcnt vmcnt(0)" ::: "memory");
        }
    }
    __syncthreads();
}


constexpr int NWAVES = 8;
constexpr int NB = 4, S = 8192, D = 1024, M = NB * S, FF = 4096;
constexpr int DIN = 2376, DINP = 2560;
constexpr int C_Q = 0, C_K = 512, C_V = 640, C_QI = 768, C_KI = 1280, C_WI = 1344, C_A = 1352, C_G = 1864;
constexpr int CONVK = 31, CCH = 512, MODW = 6 * D;
constexpr float EPS = 1e-6f;
constexpr float WI_SCALE = 0.04419417382415922f;
constexpr float SM_SCALE_LOG2E = 0.125f * 1.4426950408889634f;

constexpr size_t MiB = 1u << 20;
constexpr size_t WS_CTL = 0, CTL_ZERO_BYTES = 1 * MiB;
constexpr size_t WS_WIN = 1 * MiB, WS_WOUT = 6 * MiB, WS_WUP = 8 * MiB, WS_WDN = 16 * MiB;
constexpr size_t WS_MOD = 24 * MiB, WS_CS = 25 * MiB;
constexpr size_t WS_H = 32 * MiB;
constexpr size_t WS_PROJ = 96 * MiB;
constexpr size_t WS_Q = 256 * MiB, WS_K = 288 * MiB, WS_V = 296 * MiB, WS_QI = 304 * MiB, WS_KI = 336 * MiB, WS_WI = 340 * MiB, WS_GLU = 344 * MiB;
constexpr size_t WS_MIX = 376 * MiB;
constexpr size_t WS_U = 96 * MiB;
constexpr size_t WS_END = 440 * MiB;
constexpr int CW_BAR = 4096;

constexpr int RING_OFF = 0, RING_BYTES = 131072;
constexpr int LDSCTL_OFF = RING_BYTES, MISC_OFF = LDSCTL_OFF + 320;
constexpr int LDS_BYTES = 147456;

struct Frame {
    LAS unsigned char* lds;
    volatile LAS unsigned* MISC;
    gu32* ctl;
    int tid, lane, wave;
    int vcu, G;
    const float *x, *c, *w_ada, *b_ada, *g_mix, *w_in, *conv_w, *conv_b, *conv_ng, *conv_nb, *w_out, *g_mlp, *w_up, *w_down, *g_final;
    const int* positions;
    float* out;
    bf16 *Win_t, *Wout_t, *Wup_t, *Wdn_t;
    float *mod, *CS, *WI;
    bf16 *H, *PROJ, *Q, *K, *V, *QI, *KI, *GLU, *MIX, *U;
};

__device__ __forceinline__ float wave_sum(float v) {
#pragma unroll
    for (int o = 1; o < 64; o <<= 1) v += __shfl_xor(v, o);
    return v;
}
__device__ __forceinline__ float bf2f(unsigned u16) { return __uint_as_float(u16 << 16); }

__device__ __forceinline__ void p0_transpose_item(const float* W, int K, int N, int Npad, bf16* WT, LAS float* scr, int item, int lane) {
    const int nblk = Npad / 32, kb = item / nblk, nb = item % nblk, k0 = 64 * kb, n0 = 32 * nb;
    const int ncol = n0 + (lane & 31); const bool ok = ncol < N;
#pragma unroll 8
    for (int i = 0; i < 32; ++i) { const int kk = 2 * i + (lane >> 5); scr[kk * 33 + (lane & 31)] = ok ? W[(size_t)(k0 + kk) * N + ncol] : 0.f; }
    LDS_WAIT(); asm volatile("" ::: "memory");
    const int c = lane & 7;
#pragma unroll
    for (int j = 0; j < 4; ++j) { const int n = (lane >> 3) + 8 * j; const LAS float* s = scr + (8 * c) * 33 + n;
        v4u o; o.x = pk2(s[0 * 33], s[1 * 33]); o.y = pk2(s[2 * 33], s[3 * 33]); o.z = pk2(s[4 * 33], s[5 * 33]); o.w = pk2(s[6 * 33], s[7 * 33]);
        *(GAS v4u*)(WT + (size_t)(n0 + n) * K + k0 + 8 * c) = o; }
    LDS_WAIT(); asm volatile("" ::: "memory");
}

__device__ __forceinline__ void p0_prologue(Frame& F) {
    LAS float* cond = (LAS float*)(F.lds + 73728);
    for (int i = F.tid; i < NB * D; i += NWAVES * 64) { const float v = F.c[i]; cond[i] = v / (1.f + expf(-v)); }
    __syncthreads();
    const int gw = F.vcu * NWAVES + F.wave, NGW = F.G * NWAVES, lane = F.lane;
    for (int it = gw; it < MODW / 16; it += NGW) {
        const int col = it * 16 + (lane & 15), kg = lane >> 4;
        float a0 = 0.f, a1 = 0.f, a2 = 0.f, a3 = 0.f;
        const float* wp = F.w_ada + (size_t)kg * MODW + col;
#pragma unroll 16
        for (int i = 0; i < D / 4; ++i) { const int k = kg + 4 * i; const float w = wp[(size_t)i * 4 * MODW];
            a0 += w * cond[k]; a1 += w * cond[D + k]; a2 += w * cond[2 * D + k]; a3 += w * cond[3 * D + k]; }
        a0 += __shfl_xor(a0, 16); a0 += __shfl_xor(a0, 32); a1 += __shfl_xor(a1, 16); a1 += __shfl_xor(a1, 32);
        a2 += __shfl_xor(a2, 16); a2 += __shfl_xor(a2, 32); a3 += __shfl_xor(a3, 16); a3 += __shfl_xor(a3, 32);
        if (lane < 16) { const float bb = F.b_ada[col]; F.mod[col] = a0 + bb; F.mod[MODW + col] = a1 + bb; F.mod[2 * MODW + col] = a2 + bb; F.mod[3 * MODW + col] = a3 + bb; }
    }
    LAS float* scr = (LAS float*)(F.lds + F.wave * 8448);
    constexpr int I_IN = (D / 64) * (DINP / 32), I_OUT = (D / 64) * (D / 32), I_UP = (D / 64) * (FF / 32), I_DN = (FF / 64) * (D / 32);
    constexpr int NITEMS = I_IN + I_OUT + I_UP + I_DN;
    for (int it = gw; it < NITEMS; it += NGW) {
        int r = it;
        if (r < I_IN) { p0_transpose_item(F.w_in, D, DIN, DINP, F.Win_t, scr, r, lane); continue; } r -= I_IN;
        if (r < I_OUT) { p0_transpose_item(F.w_out, D, D, D, F.Wout_t, scr, r, lane); continue; } r -= I_OUT;
        if (r < I_UP) { p0_transpose_item(F.w_up, D, FF, FF, F.Wup_t, scr, r, lane); continue; } r -= I_UP;
        p0_transpose_item(F.w_down, FF, D, D, F.Wdn_t, scr, r, lane);
    }
    for (int i = gw * 64 + lane; i < M * 8; i += NGW * 64) {
        const int m = i >> 3, f = i & 7;
        const float invf = (f == 0) ? 1.0f : (f == 1) ? 0.1939227432012558f : (f == 2) ? 0.03760603070259094f : (f == 3) ? 0.007292664609849453f
                         : (f == 4) ? 0.0014142135623842478f : (f == 5) ? 0.00027424818836152554f : (f == 6) ? 5.3182957344688475e-05f : 1.0313385246263351e-05f;
        const float ang = (float)F.positions[m] * invf;
        const double a = (double)ang, q = rint(a * 0.63661977236758134308), rr = a - q * 1.57079632679489661923, r2 = rr * rr;
        const int n = (int)q;
        const double sn = rr * (1.0 + r2 * (-1.0 / 6 + r2 * (1.0 / 120 + r2 * (-1.0 / 5040 + r2 * (1.0 / 362880 + r2 * (-1.0 / 39916800 + r2 * (1.0 / 6227020800.0)))))));
        const double cs = 1.0 + r2 * (-0.5 + r2 * (1.0 / 24 + r2 * (-1.0 / 720 + r2 * (1.0 / 40320 + r2 * (-1.0 / 3628800 + r2 * (1.0 / 479001600 + r2 * (-1.0 / 87178291200.0)))))));
        double so, co;
        switch (n & 3) { case 0: so = sn; co = cs; break; case 1: so = cs; co = -sn; break; case 2: so = -sn; co = -cs; break; default: so = -cs; co = sn; break; }
        F.CS[(size_t)m * 16 + f] = (float)co; F.CS[(size_t)m * 16 + 8 + f] = (float)so;
    }
}

__device__ __forceinline__ void normmod_rows(Frame& F, const float* X, const float* g, const float* sh, const float* sc, bf16* out) {
    const int gw = F.vcu * NWAVES + F.wave, NGW = F.G * NWAVES, lane = F.lane;
    for (int blk = gw; blk < M / 16; blk += NGW) {
        const int r0 = blk * 16, b = r0 / S;
        f32x4 A[4], Bv[4];
#pragma unroll
        for (int j = 0; j < 4; ++j) { const int c = 4 * lane + 256 * j; const f32x4 gg = *(const f32x4*)(g + c), s1 = *(const f32x4*)(sc + (size_t)b * MODW + c);
            A[j] = gg * (s1 + 1.0f); Bv[j] = *(const f32x4*)(sh + (size_t)b * MODW + c); }
        for (int r = 0; r < 16; ++r) {
            const GAS f32x4* xr = (const GAS f32x4*)(X + (size_t)(r0 + r) * D) + lane;
            f32x4 v[4]; float ss = 0.f;
#pragma unroll
            for (int j = 0; j < 4; ++j) { v[j] = xr[64 * j]; ss += (v[j].x * v[j].x + v[j].y * v[j].y) + (v[j].z * v[j].z + v[j].w * v[j].w); }
            const float rinv = 1.0f / sqrtf(wave_sum(ss) * (1.0f / D) + EPS);
            GAS unsigned long long* o8 = (GAS unsigned long long*)(out + (size_t)(r0 + r) * D) + lane;
#pragma unroll
            for (int j = 0; j < 4; ++j) { const f32x4 y = v[j] * rinv * A[j] + Bv[j];
                o8[64 * j] = (unsigned long long)pk2(y.x, y.y) | ((unsigned long long)pk2(y.z, y.w) << 32); }
        }
    }
}
__device__ __forceinline__ void final_norm_rows(Frame& F, float* X, const float* g) {
    const int gw = F.vcu * NWAVES + F.wave, NGW = F.G * NWAVES, lane = F.lane;
    f32x4 A[4];
#pragma unroll
    for (int j = 0; j < 4; ++j) A[j] = *(const f32x4*)(g + 4 * lane + 256 * j);
    for (int blk = gw; blk < M / 16; blk += NGW) {
        for (int r = 0; r < 16; ++r) {
            GAS f32x4* xr = (GAS f32x4*)(X + (size_t)(blk * 16 + r) * D) + lane;
            f32x4 v[4]; float ss = 0.f;
#pragma unroll
            for (int j = 0; j < 4; ++j) { v[j] = xr[64 * j]; ss += (v[j].x * v[j].x + v[j].y * v[j].y) + (v[j].z * v[j].z + v[j].w * v[j].w); }
            const float rinv = 1.0f / sqrtf(wave_sum(ss) * (1.0f / D) + EPS);
#pragma unroll
            for (int j = 0; j < 4; ++j) xr[64 * j] = v[j] * rinv * A[j];
        }
    }
}

__device__ __forceinline__ void p3_post(Frame& F) {
    const int gw = F.vcu * NWAVES + F.wave, NGW = F.G * NWAVES, lane = F.lane;
    const int l31 = lane & 31; const bool rot = l31 < 8, isx1 = l31 < 4; const int i0 = 2 * (lane & 3);
    for (int blk = gw; blk < M / 16; blk += NGW) {
        for (int r = 0; r < 16; ++r) {
            const size_t m = (size_t)blk * 16 + r;
            const bf16* pr = F.PROJ + m * DINP;
            const float c0 = F.CS[m * 16 + i0], c1 = F.CS[m * 16 + i0 + 1], s0 = F.CS[m * 16 + 8 + i0], s1 = F.CS[m * 16 + 8 + i0 + 1];
#pragma unroll
            for (int j = 0; j < 11; ++j) {
                const unsigned u = *(const unsigned*)(pr + 128 * j + 2 * lane);
                float v0 = bf2f(u & 0xffffu), v1 = bf2f(u >> 16);
                if (j != 5) {
                    const float p0 = __shfl_xor(v0, 4), p1 = __shfl_xor(v1, 4);
                    if (rot && !(j == 10 && lane >= 32)) {
                        if (isx1) { v0 = v0 * c0 - p0 * s0; v1 = v1 * c1 - p1 * s1; } else { v0 = v0 * c0 + p0 * s0; v1 = v1 * c1 + p1 * s1; }
                    }
                }
                const unsigned w = pk2(v0, v1);
                if (j < 4) *(unsigned*)(F.Q + m * 512 + 128 * j + 2 * lane) = w;
                else if (j == 4) *(unsigned*)(F.K + m * 128 + 2 * lane) = w;
                else if (j == 5) *(unsigned*)(F.V + m * 128 + 2 * lane) = w;
                else if (j < 10) *(unsigned*)(F.QI + m * 512 + 128 * (j - 6) + 2 * lane) = w;
                else { if (lane < 32) *(unsigned*)(F.KI + m * 64 + 2 * lane) = w;
                       else if (lane < 36) { F.WI[m * 8 + 2 * (lane - 32)] = v0 * WI_SCALE; F.WI[m * 8 + 2 * (lane - 32) + 1] = v1 * WI_SCALE; } }
            }
#pragma unroll
            for (int j = 0; j < 4; ++j) {
                const int ch = 128 * j + 2 * lane;
                const unsigned ua = *(const unsigned*)(pr + C_A + ch), ug = *(const unsigned*)(pr + C_G + ch);
                const float a0 = bf2f(ua & 0xffffu), a1 = bf2f(ua >> 16), g0 = bf2f(ug & 0xffffu), g1 = bf2f(ug >> 16);
                *(unsigned*)(F.GLU + m * CCH + ch) = pk2(a0 / (1.f + __expf(-g0)), a1 / (1.f + __expf(-g1)));
            }
        }
    }
}

__device__ __forceinline__ void p4_conv(Frame& F) {
    LAS f32x4* wl = (LAS f32x4*)(F.lds);
    LAS unsigned char* inl = F.lds + 63488;
    const int lane = F.lane;
    for (int i = F.tid; i < CONVK * CCH; i += NWAVES * 64) { const int j = i / CCH, ch = i % CCH;
        ((LAS float*)wl)[((j * 2 + ((ch >> 2) & 1)) * 64 + (ch >> 3)) * 4 + (ch & 3)] = F.conv_w[i]; }
    f32x4 cb[2], ng[2], nb[2];
#pragma unroll
    for (int h = 0; h < 2; ++h) { cb[h] = *(const f32x4*)(F.conv_b + 8 * lane + 4 * h); ng[h] = *(const f32x4*)(F.conv_ng + 8 * lane + 4 * h); nb[h] = *(const f32x4*)(F.conv_nb + 8 * lane + 4 * h); }
    for (int tile = F.vcu; tile < M / 32; tile += F.G) {
        __syncthreads();
        const int m0 = tile * 32, s0 = m0 & (S - 1);
        for (int i = F.tid; i < 62 * 64; i += NWAVES * 64) { const int r = i >> 6, cc = i & 63;
            v4u v = (v4u){0u, 0u, 0u, 0u};
            if (s0 - 30 + r >= 0) v = *(const v4u*)(F.GLU + (size_t)(m0 - 30 + r) * CCH + cc * 8);
            *(LAS v4u*)(inl + r * 1024 + cc * 16) = v; }
        __syncthreads();
        for (int tt = 0; tt < 4; ++tt) {
            const int tl = F.wave * 4 + tt;
            f32x4 a0 = cb[0], a1 = cb[1];
#pragma unroll 2
            for (int j = 0; j < CONVK; ++j) {
                const v4u in = *(const LAS v4u*)(inl + (tl + j) * 1024 + lane * 16);
                const f32x4 w0 = wl[(j * 2 + 0) * 64 + lane], w1 = wl[(j * 2 + 1) * 64 + lane];
                const f32x4 x0 = (f32x4){bf2f(in.x & 0xffffu), bf2f(in.x >> 16), bf2f(in.y & 0xffffu), bf2f(in.y >> 16)};
                const f32x4 x1 = (f32x4){bf2f(in.z & 0xffffu), bf2f(in.z >> 16), bf2f(in.w & 0xffffu), bf2f(in.w >> 16)};
                a0 += w0 * x0; a1 += w1 * x1;
            }
            const float mean = wave_sum((a0.x + a0.y) + (a0.z + a0.w) + (a1.x + a1.y) + (a1.z + a1.w)) * (1.0f / CCH);
            a0 = a0 - mean; a1 = a1 - mean;
            const float var = wave_sum((a0.x * a0.x + a0.y * a0.y) + (a0.z * a0.z + a0.w * a0.w) + (a1.x * a1.x + a1.y * a1.y) + (a1.z * a1.z + a1.w * a1.w)) * (1.0f / CCH);
            const float rstd = 1.0f / sqrtf(var + EPS);
            f32x4 y0 = a0 * rstd * ng[0] + nb[0], y1 = a1 * rstd * ng[1] + nb[1];
            y0 = (f32x4){y0.x / (1.f + __expf(-y0.x)), y0.y / (1.f + __expf(-y0.y)), y0.z / (1.f + __expf(-y0.z)), y0.w / (1.f + __expf(-y0.w))};
            y1 = (f32x4){y1.x / (1.f + __expf(-y1.x)), y1.y / (1.f + __expf(-y1.y)), y1.z / (1.f + __expf(-y1.z)), y1.w / (1.f + __expf(-y1.w))};
            v4u o; o.x = pk2(y0.x, y0.y); o.y = pk2(y0.z, y0.w); o.z = pk2(y1.x, y1.y); o.w = pk2(y1.z, y1.w);
            *(GAS v4u*)(F.MIX + (size_t)(m0 + tl) * D + CCH + 8 * lane) = o;
        }
    }
    __syncthreads();
}

constexpr int DC = 768, DNR = DC / 64, TOPK = 256;
typedef float f32x16 __attribute__((ext_vector_type(16)));
__device__ __forceinline__ unsigned ordkey(float s, int key) {
    unsigned u = __float_as_uint(s); u = (u & 0x80000000u) ? ~u : (u | 0x80000000u);
    return (u & 0xFFFFE000u) | (unsigned)(8191 - key);
}
__device__ __forceinline__ int mbcnt64(unsigned long long mk) { return (int)__builtin_amdgcn_mbcnt_hi((unsigned)(mk >> 32), __builtin_amdgcn_mbcnt_lo((unsigned)mk, 0u)); }
__device__ __forceinline__ int dsa_compact(LAS unsigned* buf, int cnt, int lane, unsigned& thr) {
    unsigned e[DNR];
#pragma unroll
    for (int i = 0; i < DNR; ++i) { const int idx = i * 64 + lane; e[i] = idx < cnt ? buf[idx] : 0u; }
    unsigned prefix = 0u;
#pragma unroll 1
    for (int bit = 31; bit >= 0; --bit) {
        const unsigned trial = prefix | (1u << bit); int c = 0;
#pragma unroll
        for (int i = 0; i < DNR; ++i) c += __popcll(__ballot(e[i] >= trial));
        if (c >= TOPK) prefix = trial;
    }
    int base = 0;
#pragma unroll
    for (int i = 0; i < DNR; ++i) { const bool k = e[i] >= prefix; const unsigned long long mk = __ballot(k); const int pos = base + mbcnt64(mk); if (k) buf[pos] = e[i]; base += __popcll(mk); }
    thr = prefix; return base;
}

__device__ __forceinline__ void dsa_unit(Frame& F, int b, int t0, LAS unsigned* cw) {
    const int lane = F.lane, r = lane & 31, hi = lane >> 5;
    const size_t mb = (size_t)b * S;
    const int a_ = r >> 2, i_ = r & 3, ql = ((a_ >> 2) & 1) + 2 * (a_ & 1), hd = 4 * ((a_ >> 1) & 1) + i_;
    const bf16* qip = F.QI + (mb + t0 + ql) * 512 + hd * 64 + hi * 8;
    bf16x8 A[4];
#pragma unroll
    for (int ks = 0; ks < 4; ++ks) A[ks] = *(const bf16x8*)(qip + ks * 16);
    float wv[16];
    { const f32x4* wp = (const f32x4*)(F.WI + (mb + t0 + 2 * hi) * 8);
#pragma unroll
      for (int q4 = 0; q4 < 4; ++q4) { const f32x4 t = wp[q4]; wv[4 * q4] = t.x; wv[4 * q4 + 1] = t.y; wv[4 * q4 + 2] = t.z; wv[4 * q4 + 3] = t.w; } }
    const int tA = t0 + 2 * hi, tB = tA + 1;
    int cnt0 = 0, cnt1 = 0, cnt2 = 0, cnt3 = 0; unsigned tau0 = 0u, tau1 = 0u, tau2 = 0u, tau3 = 0u;
    const bf16* kip = F.KI + (mb + r) * 64 + hi * 8;
    const int nsub = ((t0 + 3) >> 5) + 1;
#define DSA_APPEND(pred, pk, cntL, cntH, qL, qH) do { const unsigned long long mk_ = __ballot(pred); const unsigned lo_ = (unsigned)mk_, hh_ = (unsigned)(mk_ >> 32); \
        const int pos_ = hi ? (cntH + (int)__builtin_amdgcn_mbcnt_hi(hh_, 0u)) : (cntL + (int)__builtin_amdgcn_mbcnt_lo(lo_, 0u)); \
        if (pred) cw[(hi ? (qH) : (qL)) * DC + pos_] = (pk); cntL += __popc(lo_); cntH += __popc(hh_); } while (0)
#pragma unroll 1
    for (int st = 0; st < nsub; ++st) {
        const int s0 = st * 32; const bf16* kp = kip + (size_t)s0 * 64;
        const bf16x8 B0 = *(const bf16x8*)(kp), B1 = *(const bf16x8*)(kp + 16), B2 = *(const bf16x8*)(kp + 32), B3 = *(const bf16x8*)(kp + 48);
        f32x16 acc = {0.f, 0.f, 0.f, 0.f, 0.f, 0.f, 0.f, 0.f, 0.f, 0.f, 0.f, 0.f, 0.f, 0.f, 0.f, 0.f};
        acc = __builtin_amdgcn_mfma_f32_32x32x16_bf16(A[0], B0, acc, 0, 0, 0);
        acc = __builtin_amdgcn_mfma_f32_32x32x16_bf16(A[1], B1, acc, 0, 0, 0);
        acc = __builtin_amdgcn_mfma_f32_32x32x16_bf16(A[2], B2, acc, 0, 0, 0);
        acc = __builtin_amdgcn_mfma_f32_32x32x16_bf16(A[3], B3, acc, 0, 0, 0);
        float sc0 = 0.f, sc1 = 0.f;
#pragma unroll
        for (int g = 0; g < 8; ++g) { sc0 = fmaf(wv[g], fmaxf(acc[g], 0.f), sc0); sc1 = fmaf(wv[8 + g], fmaxf(acc[8 + g], 0.f), sc1); }
        const int key = s0 + r;
        const unsigned pk0 = ordkey(sc0, key), pk1 = ordkey(sc1, key);
        const unsigned tauA = hi ? tau2 : tau0, tauB = hi ? tau3 : tau1;
        const bool p0 = (key <= tA) && (pk0 > tauA), p1 = (key <= tB) && (pk1 > tauB);
        DSA_APPEND(p0, pk0, cnt0, cnt2, 0, 2);
        DSA_APPEND(p1, pk1, cnt1, cnt3, 1, 3);
        if (cnt0 > DC - 32) cnt0 = dsa_compact(cw + 0 * DC, cnt0, lane, tau0);
        if (cnt1 > DC - 32) cnt1 = dsa_compact(cw + 1 * DC, cnt1, lane, tau1);
        if (cnt2 > DC - 32) cnt2 = dsa_compact(cw + 2 * DC, cnt2, lane, tau2);
        if (cnt3 > DC - 32) cnt3 = dsa_compact(cw + 3 * DC, cnt3, lane, tau3);
    }
#undef DSA_APPEND
    if (cnt0 > TOPK) cnt0 = dsa_compact(cw + 0 * DC, cnt0, lane, tau0);
    if (cnt1 > TOPK) cnt1 = dsa_compact(cw + 1 * DC, cnt1, lane, tau1);
    if (cnt2 > TOPK) cnt2 = dsa_compact(cw + 2 * DC, cnt2, lane, tau2);
    if (cnt3 > TOPK) cnt3 = dsa_compact(cw + 3 * DC, cnt3, lane, tau3);
    const int fr = lane & 15, fq = lane >> 4;
#define DSA_PADDR(n) ((((n) >> 6) * DC + 256 + ((n) & 63) * 8))
#pragma unroll 1
    for (int q = 0; q < 4; ++q) {
        const int nsel = (q == 0) ? cnt0 : (q == 1) ? cnt1 : (q == 2) ? cnt2 : cnt3;
        const int t = t0 + q;
        const LAS unsigned* sel = cw + q * DC;
        bf16x8 Bq[4];
#pragma unroll
        for (int ks = 0; ks < 4; ++ks) { const bool ok = (fr < 8) && ((fr >> 2) == (ks >> 1));
            bf16x8 v = {0, 0, 0, 0, 0, 0, 0, 0};
            if (ok) v = *(const bf16x8*)(F.Q + (mb + t) * 512 + fr * 64 + (ks & 1) * 32 + fq * 8);
            Bq[ks] = v; }
        f32x4 lg[16];
#pragma unroll
        for (int T = 0; T < 16; ++T) {
            const int n = 16 * T + fr;
            const int sidx = (n < nsel) ? (8191 - (int)(sel[n] & 0x1FFFu)) : 0;
            const bf16* kp = F.K + (mb + sidx) * 128 + fq * 8;
            f32x4 a4 = {0.f, 0.f, 0.f, 0.f};
#pragma unroll
            for (int ks = 0; ks < 4; ++ks) a4 = __builtin_amdgcn_mfma_f32_16x16x32_bf16(*(const bf16x8*)(kp + ks * 32), Bq[ks], a4, 0, 0, 0);
            lg[T] = a4;
            if (T & 1) asm volatile("" ::: "memory");
        }
        float mx = -INFINITY;
#pragma unroll
        for (int T = 0; T < 16; ++T)
#pragma unroll
            for (int g = 0; g < 4; ++g) { const int n = 16 * T + 4 * fq + g; const float xv = (n < nsel) ? lg[T][g] * SM_SCALE_LOG2E : -INFINITY; lg[T][g] = xv; mx = fmaxf(mx, xv); }
        mx = fmaxf(mx, __shfl_xor(mx, 16)); mx = fmaxf(mx, __shfl_xor(mx, 32));
        float sm = 0.f;
#pragma unroll
        for (int T = 0; T < 16; ++T)
#pragma unroll
            for (int g = 0; g < 4; ++g) { const float p = __builtin_amdgcn_exp2f(lg[T][g] - mx); lg[T][g] = p; sm += p; }
        sm += __shfl_xor(sm, 16); sm += __shfl_xor(sm, 32);
        const float inv = 1.0f / sm;
        if (fr < 8) {
#pragma unroll
            for (int T = 0; T < 16; ++T)
#pragma unroll
                for (int g = 0; g < 4; ++g) { const int n = 16 * T + 4 * fq + g; ((LAS float*)cw)[DSA_PADDR(n) + fr] = lg[T][g] * inv; }
        }
        const int kh = hi;
        float o00 = 0.f, o01 = 0.f, o10 = 0.f, o11 = 0.f, o20 = 0.f, o21 = 0.f, o30 = 0.f, o31 = 0.f;
        const bf16* vb = F.V + mb * 128 + 2 * lane;
#pragma unroll 4
        for (int n = 0; n < TOPK; ++n) {
            const int sidx = (n < nsel) ? (8191 - (int)(sel[n] & 0x1FFFu)) : 0;
            const f32x4 p = *(const LAS f32x4*)((const LAS float*)cw + DSA_PADDR(n) + kh * 4);
            const unsigned u = *(const unsigned*)(vb + (size_t)sidx * 128);
            const float v0 = bf2f(u & 0xffffu), v1 = bf2f(u >> 16);
            o00 += p.x * v0; o01 += p.x * v1; o10 += p.y * v0; o11 += p.y * v1; o20 += p.z * v0; o21 += p.z * v1; o30 += p.w * v0; o31 += p.w * v1;
        }
        bf16* op = F.MIX + (mb + t) * D + (kh * 4) * 64 + 2 * (lane & 31);
        *(unsigned*)(op) = pk2(o00, o01); *(unsigned*)(op + 64) = pk2(o10, o11); *(unsigned*)(op + 128) = pk2(o20, o21); *(unsigned*)(op + 192) = pk2(o30, o31);
    }
#undef DSA_PADDR
}
__device__ __forceinline__ void p4_dsa(Frame& F) {
    LAS unsigned* cw = (LAS unsigned*)(F.lds + F.wave * (DC * 16));
    const int gw = F.vcu * NWAVES + F.wave, NGW = F.G * NWAVES;
    for (int w = gw; w < 2048; w += NGW) {
        const int b = w >> 9, j = w & 511;
#pragma unroll 1
        for (int k = 0; k < 4; ++k) { const int u = (k == 0) ? j : (k == 1) ? 1023 - j : (k == 2) ? 1024 + j : 2047 - j; dsa_unit(F, b, 4 * u, cw); }
    }
}

struct Args { const void* in[16]; float* out; unsigned char* ws; };
__global__ void __launch_bounds__(NWAVES * 64, 2) fwd_kernel(Args args) {
    extern __shared__ __attribute__((aligned(16))) unsigned char lds[];
    Frame F;
    F.lds = (LAS unsigned char*)lds;
    F.MISC = (volatile LAS unsigned*)(F.lds + MISC_OFF);
    F.tid = threadIdx.x; F.lane = F.tid & 63; F.wave = __builtin_amdgcn_readfirstlane(F.tid >> 6);
    F.G = gridDim.x; { const int bx = blockIdx.x; F.vcu = (F.G % 8 == 0) ? (bx % 8) * (F.G / 8) + bx / 8 : bx; }
    unsigned char* ws = args.ws;
    F.ctl = (gu32*)(ws + WS_CTL);
    F.x = (const float*)args.in[0]; F.c = (const float*)args.in[1]; F.positions = (const int*)args.in[2]; F.w_ada = (const float*)args.in[3]; F.b_ada = (const float*)args.in[4];
    F.g_mix = (const float*)args.in[5]; F.w_in = (const float*)args.in[6]; F.conv_w = (const float*)args.in[7]; F.conv_b = (const float*)args.in[8]; F.conv_ng = (const float*)args.in[9];
    F.conv_nb = (const float*)args.in[10]; F.w_out = (const float*)args.in[11]; F.g_mlp = (const float*)args.in[12]; F.w_up = (const float*)args.in[13]; F.w_down = (const float*)args.in[14];
    F.g_final = (const float*)args.in[15]; F.out = args.out;
    F.Win_t = (bf16*)(ws + WS_WIN); F.Wout_t = (bf16*)(ws + WS_WOUT); F.Wup_t = (bf16*)(ws + WS_WUP); F.Wdn_t = (bf16*)(ws + WS_WDN);
    F.mod = (float*)(ws + WS_MOD); F.CS = (float*)(ws + WS_CS); F.WI = (float*)(ws + WS_WI);
    F.H = (bf16*)(ws + WS_H); F.PROJ = (bf16*)(ws + WS_PROJ); F.Q = (bf16*)(ws + WS_Q); F.K = (bf16*)(ws + WS_K); F.V = (bf16*)(ws + WS_V); F.QI = (bf16*)(ws + WS_QI);
    F.KI = (bf16*)(ws + WS_KI); F.GLU = (bf16*)(ws + WS_GLU); F.MIX = (bf16*)(ws + WS_MIX); F.U = (bf16*)(ws + WS_U);
    for (int u = F.tid; u < (LDS_BYTES - LDSCTL_OFF) / 4; u += NWAVES * 64) ((LAS unsigned*)(F.lds + LDSCTL_OFF))[u] = 0u;
    __syncthreads();
    XcdBarrier bar = xcd_barrier_post((unsigned*)(F.ctl + CW_BAR), F.MISC + 8);
#define GRID_BAR() xcd_barrier(bar)
    const float* sh1 = F.mod, *sc1 = F.mod + D, *gt1 = F.mod + 2 * D, *sh2 = F.mod + 3 * D, *sc2 = F.mod + 4 * D, *gt2 = F.mod + 5 * D;

    p0_prologue(F); GRID_BAR();
    normmod_rows(F, F.x, F.g_mix, sh1, sc1, F.H); GRID_BAR();
    { pg8::Gemm g{F.H, F.Win_t, M, DINP, D}; pg8::StaticOrder So; So.init(M, DINP, F.G, (int)blockIdx.x);
      pg8::EpiBf16<0> E{F.PROJ, DINP, nullptr, 0, 0, 1.f};
      pg8::gemm_phase<pg8::EpiBf16<0>, pg8::StaticOrder, true, true>(F.lds + RING_OFF, g, So, E); }
    GRID_BAR();
    p3_post(F); GRID_BAR();
    p4_conv(F); p4_dsa(F); GRID_BAR();
    { pg8::Gemm g{F.MIX, F.Wout_t, M, D, D}; pg8::StaticOrder So; So.init(M, D, F.G, (int)blockIdx.x);
      pg8::EpiResGate E{F.x, F.out, D, gt1, MODW, S};
      pg8::gemm_phase<pg8::EpiResGate, pg8::StaticOrder, true, true>(F.lds + RING_OFF, g, So, E); }
    GRID_BAR();
    normmod_rows(F, F.out, F.g_mlp, sh2, sc2, F.H); GRID_BAR();
    { pg8::Gemm g{F.H, F.Wup_t, M, FF, D}; pg8::StaticOrder So; So.init(M, FF, F.G, (int)blockIdx.x);
      pg8::EpiBf16<2> E{F.U, FF, nullptr, 0, 0, 1.f};
      pg8::gemm_phase<pg8::EpiBf16<2>, pg8::StaticOrder, true, true>(F.lds + RING_OFF, g, So, E); }
    GRID_BAR();
    { pg8::Gemm g{F.U, F.Wdn_t, M, D, FF}; pg8::StaticOrder So; So.init(M, D, F.G, (int)blockIdx.x);
      pg8::EpiResGate E{F.out, F.out, D, gt2, MODW, S};
      pg8::gemm_phase<pg8::EpiResGate, pg8::StaticOrder, true, true>(F.lds + RING_OFF, g, So, E); }
    GRID_BAR();
    final_norm_rows(F, F.out, F.g_final);
#undef GRID_BAR
}

extern "C" void kernel_launch(void* const* d_in, const int* in_sizes, int n_in, void* d_out, int out_size, void* d_ws, size_t ws_size, hipStream_t stream) {
    static int grid = 0;
    if (grid == 0) {
        if (n_in != 16 || in_sizes[0] != M * D || out_size != M * D || ws_size < WS_END) { fprintf(stderr, "kernel_launch: unexpected shapes (n_in %d, in0 %d, out %d, ws %zu); nothing launched\n", n_in, n_in > 0 ? in_sizes[0] : -1, out_size, ws_size); grid = -1; return; }
        int dev = 0, cus = 0, per_cu = 0;
        if (hipGetDevice(&dev) != hipSuccess || hipDeviceGetAttribute(&cus, hipDeviceAttributeMultiprocessorCount, dev) != hipSuccess) { grid = -1; return; }
        if (hipFuncSetAttribute((const void*)fwd_kernel, hipFuncAttributeMaxDynamicSharedMemorySize, LDS_BYTES) != hipSuccess) { fprintf(stderr, "kernel_launch: hipFuncSetAttribute failed\n"); grid = -1; return; }
        if (hipOccupancyMaxActiveBlocksPerMultiprocessor(&per_cu, (const void*)fwd_kernel, NWAVES * 64, LDS_BYTES) != hipSuccess || per_cu < 1) { fprintf(stderr, "kernel_launch: occupancy query says %d blocks per CU; nothing launched\n", per_cu); (void)hipGetLastError(); grid = -1; return; }
        grid = cus;
    }
    if (grid < 0) return;
    if (hipMemsetAsync((char*)d_ws + WS_CTL, 0, CTL_ZERO_BYTES, stream) != hipSuccess) { fprintf(stderr, "kernel_launch: memset failed\n"); return; }
    Args a{};
    for (int i = 0; i < 16; ++i) a.in[i] = d_in[i];
    a.out = (float*)d_out; a.ws = (unsigned char*)d_ws;
    hipLaunchKernelGGL(fwd_kernel, dim3(grid), dim3(NWAVES * 64), LDS_BYTES, stream, a);
}
```

```cpp
#include <cmath>
#include <hip/hip_runtime.h>
#include <cstdio>
#include <cstdint>
namespace pg8 {
#define PG8_LAS __attribute__((address_space(3)))
typedef unsigned short bf16_t;
typedef short bf16x8 __attribute__((ext_vector_type(8)));
typedef float f32x4 __attribute__((ext_vector_type(4)));
typedef unsigned u32x4 __attribute__((ext_vector_type(4)));
constexpr int BM = 256, BK = 64, HALF = 128, HTB = HALF * BK * 2  , STAGE_BYTES = 8 * HTB, NXCD = 8, WGM = 8;

__host__ __device__ __forceinline__ int lds_byte(int r, int c) { const int st = (r >> 4) * 2 + (c >> 5), rr = r & 15, cc = c & 31, ob = rr * 64 + cc * 2; return st * 1024 + (ob ^ (((ob >> 9) & 1) << 5)); }
__host__ __device__ __forceinline__ void stage_rc(int b, int& R, int& C) { const int st = b / 1024, sb = b % 1024, swz = sb ^ (((sb >> 9) & 1) << 5); R = (st >> 1) * 16 + swz / 64; C = (st & 1) * 32 + (swz % 64) / 2; }
__host__ __device__ __forceinline__ int perm32(int rho) { const int n = rho >> 4, i = rho & 15; return 8 * (i >> 2) + 4 * n + (i & 3); }

struct Unit { int pm, pn; };
struct Gemm { const bf16_t* A; const bf16_t* Bt; int M, N, K; };

struct StaticOrder {
    int nM, nN, nwg, G, c;
    __host__ __device__ void init(int M, int N, int G_, int c_) { nM = M / BM; nN = N / BM; nwg = nM * nN; G = G_; c = c_; }
    __host__ __device__ bool next(int i, Unit& u) const {
        const long L = (long)i * G + c; if (L >= nwg) return false;
        int wgid = (int)L; { const int q = nwg / NXCD, r = nwg % NXCD, xcd = wgid % NXCD, off = wgid / NXCD; wgid = (xcd < r ? xcd * (q + 1) : r * (q + 1) + (xcd - r) * q) + off; }
        const int nig = WGM * nN, gid = wgid / nig, fm = gid * WGM, gsz = (nM - fm) < WGM ? (nM - fm) : WGM;
        u.pm = fm + ((wgid % nig) % gsz); u.pn = (wgid % nig) / gsz; return true;
    }
    __device__ __forceinline__ void a_ready(const Unit&) const {}
    __device__ __forceinline__ void done(const Unit&) const {}
};

__device__ __forceinline__ unsigned cvt_pk_bf16(float lo, float hi) { unsigned r; asm volatile("v_cvt_pk_bf16_f32 %0, %1, %2" : "=v"(r) : "v"(lo), "v"(hi)); return r; }
typedef float f32x2 __attribute__((ext_vector_type(2)));
__device__ __forceinline__ f32x2 gelu_pk(f32x2 v) {
    const f32x2 av = __builtin_elementwise_abs(v), d = av * 0.2316418882f + 1.0f;
    f32x2 t; t.x = __builtin_amdgcn_rcpf(d.x); t.y = __builtin_amdgcn_rcpf(d.y);
    f32x2 q = t * 0.5307027145f + (-0.7265760135f); q = q * t + 0.7107068705f; q = q * t + (-0.142248368f); q = q * t + 0.127414796f; q = q * t;
    const f32x2 s = (v * v) * (-0.72134752044f);
    f32x2 e; e.x = __builtin_amdgcn_exp2f(s.x); e.y = __builtin_amdgcn_exp2f(s.y);
    const f32x2 m = v * (q * e), r = v - m;
    f32x2 o; o.x = v.x < 0.f ? m.x : r.x; o.y = v.y < 0.f ? m.y : r.y; return o;
}

template <int ACT  > struct EpiBf16 {
    static constexpr bool PERM = true, AFTER_DRAIN = false; static_assert(ACT == 0 || ACT == 1 || ACT == 2, "EpiBf16: ACT is 0 (none), 1 (gelu_pk) or 2 (squared relu)");
    bf16_t* O; int ldc; const float* bias; int split_cols; size_t split_stride; float scale0;
    __device__ __forceinline__ void operator()(const f32x4 (&acc)[2][2][4][2], const Unit& u, int wr, int wc, int fr, int fq) const {
        const int row0 = u.pm * BM + wr * 64 + fr; int colt = u.pn * BM; bf16_t* base = O;
        float sc = 1.f; if (split_cols) { const int t = colt / split_cols; base += (size_t)t * split_stride; colt -= t * split_cols; if (t == 0) sc = scale0; }
        const int col0 = colt + wc * 32 + 8 * fq, bcol0 = u.pn * BM + wc * 32 + 8 * fq;
        f32x4 bv[2][2];
#pragma unroll
        for (int bj = 0; bj < 2; ++bj)
#pragma unroll
            for (int n = 0; n < 2; ++n) bv[bj][n] = bias ? *(const f32x4*)(bias + bcol0 + bj * HALF + 4 * n) : (f32x4){0.f, 0.f, 0.f, 0.f};
#pragma unroll
        for (int ai = 0; ai < 2; ++ai)
#pragma unroll
            for (int m = 0; m < 4; ++m) { bf16_t* rowp = base + (size_t)(row0 + ai * HALF + m * 16) * ldc + col0;
#pragma unroll
                for (int bj = 0; bj < 2; ++bj) { f32x4 v0 = acc[ai][bj][m][0] + bv[bj][0], v1 = acc[ai][bj][m][1] + bv[bj][1];
                    if (ACT == 1) { f32x2 a = gelu_pk((f32x2){v0[0], v0[1]}), b = gelu_pk((f32x2){v0[2], v0[3]}), c = gelu_pk((f32x2){v1[0], v1[1]}), d = gelu_pk((f32x2){v1[2], v1[3]});
                        v0 = (f32x4){a.x, a.y, b.x, b.y}; v1 = (f32x4){c.x, c.y, d.x, d.y}; }
                    if (ACT == 2) { v0 = __builtin_elementwise_max(v0, (f32x4){0.f, 0.f, 0.f, 0.f}); v1 = __builtin_elementwise_max(v1, (f32x4){0.f, 0.f, 0.f, 0.f}); v0 = v0 * v0; v1 = v1 * v1; }
                    v0 = v0 * sc; v1 = v1 * sc; u32x4 w; w.x = cvt_pk_bf16(v0[0], v0[1]); w.y = cvt_pk_bf16(v0[2], v0[3]); w.z = cvt_pk_bf16(v1[0], v1[1]); w.w = cvt_pk_bf16(v1[2], v1[3]);
                    *(u32x4*)(rowp + bj * HALF) = w; } }
    }
};


struct EpiResGate {
    static constexpr bool PERM = false, AFTER_DRAIN = false;
    const float* base; float* out; int ldc; const float* gate; int gate_stride; int rows_per_batch;
    __device__ __forceinline__ void operator()(const f32x4 (&acc)[2][2][4][2], const Unit& u, int wr, int wc, int fr, int fq) const {
        const int row0 = u.pm * BM + wr * 64 + fr, col0 = u.pn * BM + wc * 32 + 4 * fq;
        const float* gp = gate + (size_t)((u.pm * BM) / rows_per_batch) * gate_stride + col0;
        f32x4 gv[2][2];
#pragma unroll
        for (int bj = 0; bj < 2; ++bj)
#pragma unroll
            for (int n = 0; n < 2; ++n) gv[bj][n] = *(const f32x4*)(gp + bj * HALF + n * 16);
#pragma unroll
        for (int ai = 0; ai < 2; ++ai)
#pragma unroll
            for (int m = 0; m < 4; ++m) { const size_t off = (size_t)(row0 + ai * HALF + m * 16) * ldc + col0;
#pragma unroll
                for (int bj = 0; bj < 2; ++bj)
#pragma unroll
                    for (int n = 0; n < 2; ++n) { const f32x4 bs = *(const f32x4*)(base + off + bj * HALF + n * 16); *(f32x4*)(out + off + bj * HALF + n * 16) = bs + gv[bj][n] * acc[ai][bj][m][n]; }
                if (m & 1) asm volatile("" ::: "memory"); }
    }
};

template <class Epi, class Sched, bool ALIGN_EPI = false, bool SP2 = false>
__device__ __forceinline__ void gemm_phase(PG8_LAS unsigned char* lds, const Gemm g, const Sched& S, const Epi& E) {
    int tid_ = threadIdx.x; asm volatile("" : "+v"(tid_));
    const int tid = tid_, wid = __builtin_amdgcn_readfirstlane(tid >> 6), lane = tid & 63, wr = wid >> 2, wc = wid & 3, fr = lane & 15, fq = lane >> 4;
    const int K = g.K, nt = K / BK;
    unsigned voffA[2], voffB[2];
#pragma unroll
    for (int i = 0; i < 2; ++i) { int R, C; stage_rc(tid * 16 + i * 8192, R, C); const int Rb = Epi::PERM ? ((R & ~31) + perm32(R & 31)) : R;
        voffA[i] = (unsigned)(R * K + C) * 2u; voffB[i] = (unsigned)(Rb * K + C) * 2u; }
    const size_t kstep = (size_t)(BK * 2);
    const size_t hstep = (size_t)HALF * K * 2;
    const size_t tstep = 2 * hstep;
    const unsigned ldsw = (unsigned)wid * 1024u;
    const int aoff = lds_byte(wr * 64 + fr, fq * 8), boff = lds_byte(wc * 32 + fr, fq * 8);
#define PG8_SA(b, h) (((b) * 2 + (h)) * HTB)
#define PG8_SB(b, h) ((4 + (b) * 2 + (h)) * HTB)
#define PG8_STAGE(bufoff, gbase, voff) do { _Pragma("unroll") for (int _i = 0; _i < 2; ++_i) \
        __builtin_amdgcn_global_load_lds((const unsigned*)((const char*)(gbase) + (voff)[_i]), (PG8_LAS unsigned*)(lds + (bufoff) + ldsw + _i * 8192), 16, 0, 0); } while (0)
#define PG8_LDA(dst, b, h) do { _Pragma("unroll") for (int m = 0; m < 4; ++m) _Pragma("unroll") for (int k = 0; k < 2; ++k) dst[m][k] = *(const PG8_LAS bf16x8*)(lds + PG8_SA(b, h) + aoff + m * 2048 + k * 1024); } while (0)
#define PG8_LDB(dst, b, h) do { _Pragma("unroll") for (int n = 0; n < 2; ++n) _Pragma("unroll") for (int k = 0; k < 2; ++k) dst[n][k] = *(const PG8_LAS bf16x8*)(lds + PG8_SB(b, h) + boff + n * 2048 + k * 1024); } while (0)
#define PG8_MMA(ai, bj, At, Bt) do { __builtin_amdgcn_s_setprio(1); _Pragma("unroll") for (int m = 0; m < 4; ++m) _Pragma("unroll") for (int n = 0; n < 2; ++n) _Pragma("unroll") for (int k = 0; k < 2; ++k) \
        acc[ai][bj][m][n] = __builtin_amdgcn_mfma_f32_16x16x32_bf16(Bt[n][k], At[m][k], acc[ai][bj][m][n], 0, 0, 0); __builtin_amdgcn_s_setprio(0); } while (0)
#define PG8_WAIT_V(n) asm volatile("s_waitcnt vmcnt(" #n ")" ::: "memory")
#define PG8_WAIT_L(n) asm volatile("s_waitcnt lgkmcnt(" #n ")" ::: "memory")
#define PG8_BAR __builtin_amdgcn_s_barrier()
#define PG8_SCHED __builtin_amdgcn_sched_barrier(0)
    Unit cur, nxt; int ui = 0;
    if (!S.next(0, cur)) return;
    f32x4 acc[2][2][4][2];
#pragma unroll
    for (int a = 0; a < 2; ++a)
#pragma unroll
        for (int b = 0; b < 2; ++b)
#pragma unroll
            for (int m = 0; m < 4; ++m)
#pragma unroll
                for (int n = 0; n < 2; ++n) acc[a][b][m][n] = (f32x4){0.f, 0.f, 0.f, 0.f};
    bf16x8 At[4][2], B0[2][2], B1[2][2];
    const char* cA = (const char*)g.A + (size_t)cur.pm * tstep; const char* cB = (const char*)g.Bt + (size_t)cur.pn * tstep;
    S.a_ready(cur);
    if constexpr (SP2) {
        PG8_STAGE(PG8_SB(0, 0), cB, voffB); PG8_STAGE(PG8_SB(0, 1), cB + hstep, voffB); PG8_STAGE(PG8_SA(0, 0), cA, voffA); PG8_STAGE(PG8_SA(0, 1), cA + hstep, voffA);
        if (wr == 1) PG8_BAR;
        PG8_WAIT_V(2); PG8_BAR;
        PG8_STAGE(PG8_SB(1, 0), cB + kstep, voffB); PG8_STAGE(PG8_SA(1, 0), cA + kstep, voffA); PG8_STAGE(PG8_SB(1, 1), cB + hstep + kstep, voffB);
        PG8_WAIT_V(6); PG8_BAR;
    } else {
        PG8_STAGE(PG8_SB(0, 0), cB, voffB); PG8_STAGE(PG8_SA(0, 0), cA, voffA); PG8_STAGE(PG8_SB(0, 1), cB + hstep, voffB); PG8_STAGE(PG8_SA(0, 1), cA + hstep, voffA);
        if (wr == 1) PG8_BAR;
        PG8_WAIT_V(4); PG8_BAR;
        PG8_STAGE(PG8_SB(1, 0), cB + kstep, voffB); PG8_STAGE(PG8_SA(1, 0), cA + kstep, voffA); PG8_STAGE(PG8_SB(1, 1), cB + hstep + kstep, voffB);
        PG8_WAIT_V(6); PG8_BAR;
    }
    for (;;) {
        const bool has_next = S.next(ui + 1, nxt);
        const char* nA = has_next ? (const char*)g.A + (size_t)nxt.pm * tstep : cA; const char* nB = has_next ? (const char*)g.Bt + (size_t)nxt.pn * tstep : cB;
        for (int t = 0; t < nt; t += 2) {
            const bool last = (t == nt - 2);
            const char* a1 = cA + (size_t)(t + 1) * kstep;
            const char* a2 = last ? nA : cA + (size_t)(t + 2) * kstep; const char* b2 = last ? nB : cB + (size_t)(t + 2) * kstep;
            const char* a3 = a2 + kstep; const char* b3 = b2 + kstep;
            if (last && has_next) S.a_ready(nxt);
            if constexpr (SP2) {
            PG8_LDB(B0, 0, 0); PG8_LDB(B1, 0, 1); PG8_SCHED; PG8_LDA(At, 0, 0); PG8_STAGE(PG8_SA(1, 1), a1 + hstep, voffA);
            PG8_WAIT_V(8); PG8_WAIT_L(0); PG8_BAR; PG8_MMA(0, 0, At, B0); PG8_MMA(0, 1, At, B1); PG8_BAR; PG8_SCHED;
            PG8_LDA(At, 0, 1); PG8_STAGE(PG8_SB(0, 0), b2, voffB); PG8_STAGE(PG8_SB(0, 1), b2 + hstep, voffB); PG8_STAGE(PG8_SA(0, 0), a2, voffA);
            PG8_WAIT_V(8); PG8_WAIT_L(0); PG8_BAR; PG8_MMA(1, 0, At, B0); PG8_MMA(1, 1, At, B1); PG8_BAR; PG8_SCHED;
            PG8_LDB(B0, 1, 0); PG8_LDB(B1, 1, 1); PG8_SCHED; PG8_LDA(At, 1, 0); PG8_STAGE(PG8_SA(0, 1), a2 + hstep, voffA);
            PG8_WAIT_V(8); PG8_WAIT_L(0); PG8_BAR; PG8_MMA(0, 0, At, B0); PG8_MMA(0, 1, At, B1); PG8_BAR; PG8_SCHED;
            PG8_LDA(At, 1, 1); PG8_STAGE(PG8_SB(1, 0), b3, voffB); PG8_STAGE(PG8_SB(1, 1), b3 + hstep, voffB); PG8_STAGE(PG8_SA(1, 0), a3, voffA);
            PG8_WAIT_V(8); PG8_WAIT_L(0); PG8_BAR; PG8_MMA(1, 0, At, B0); PG8_MMA(1, 1, At, B1); PG8_BAR; PG8_SCHED;
            } else {
            PG8_LDB(B0, 0, 0); PG8_SCHED; PG8_LDA(At, 0, 0); PG8_STAGE(PG8_SA(1, 1), a1 + hstep, voffA);
            PG8_WAIT_L(8); PG8_BAR; PG8_WAIT_L(0); PG8_MMA(0, 0, At, B0); PG8_BAR; PG8_SCHED;
            PG8_LDB(B1, 0, 1); PG8_STAGE(PG8_SB(0, 0), b2, voffB);
            PG8_BAR; PG8_WAIT_L(0); PG8_MMA(0, 1, At, B1); PG8_BAR;
            PG8_LDA(At, 0, 1); PG8_STAGE(PG8_SA(0, 0), a2, voffA);
            PG8_BAR; PG8_WAIT_L(0); PG8_MMA(1, 0, At, B0); PG8_BAR; PG8_SCHED;
            PG8_STAGE(PG8_SB(0, 1), b2 + hstep, voffB);
            PG8_WAIT_V(6); PG8_BAR; PG8_MMA(1, 1, At, B1); PG8_BAR;
            PG8_LDB(B0, 1, 0); PG8_SCHED; PG8_LDA(At, 1, 0); PG8_STAGE(PG8_SA(0, 1), a2 + hstep, voffA);
            PG8_WAIT_L(8); PG8_BAR; PG8_WAIT_L(0); PG8_MMA(0, 0, At, B0); PG8_BAR; PG8_SCHED;
            PG8_LDB(B1, 1, 1); PG8_STAGE(PG8_SB(1, 0), b3, voffB);
            PG8_BAR; PG8_WAIT_L(0); PG8_MMA(0, 1, At, B1); PG8_BAR;
            PG8_LDA(At, 1, 1); PG8_STAGE(PG8_SA(1, 0), a3, voffA);
            PG8_BAR; PG8_WAIT_L(0); PG8_MMA(1, 0, At, B0); PG8_BAR; PG8_SCHED;
            PG8_STAGE(PG8_SB(1, 1), b3 + hstep, voffB);
            PG8_WAIT_V(6); PG8_BAR; PG8_MMA(1, 1, At, B1); PG8_BAR;
            }
        }
        if constexpr (ALIGN_EPI) { if (wr == 0) PG8_BAR; }
        if constexpr (!Epi::AFTER_DRAIN) { E(acc, cur, wr, wc, fr, fq); S.done(cur); }
        if (!has_next) break;
#pragma unroll
        for (int a = 0; a < 2; ++a)
#pragma unroll
            for (int b = 0; b < 2; ++b)
#pragma unroll
                for (int m = 0; m < 4; ++m)
#pragma unroll
                    for (int n = 0; n < 2; ++n) acc[a][b][m][n] = (f32x4){0.f, 0.f, 0.f, 0.f};
        cur = nxt; cA = nA; cB = nB; ++ui;
        if constexpr (ALIGN_EPI) { if (wr == 1) PG8_BAR; }
    }
    PG8_WAIT_V(0);
    if constexpr (!ALIGN_EPI) { if (wr == 0) PG8_BAR; }
    PG8_BAR;
    if constexpr (Epi::AFTER_DRAIN) { E.fused(acc, cur, wr, wc, fr, fq, lds, wid, lane); S.done(cur); }
#undef PG8_SA
#undef PG8_SB
#undef PG8_STAGE
#undef PG8_LDA
#undef PG8_LDB
#undef PG8_MMA
#undef PG8_WAIT_V
#undef PG8_WAIT_L
#undef PG8_BAR
#undef PG8_SCHED
}
}

#ifndef PG8_SP2
#define PG8_SP2 true
#endif
#ifndef PG8_ALIGN
#define PG8_ALIGN true
#endif
#define GAS __attribute__((address_space(1)))
#define LAS __attribute__((address_space(3)))
typedef unsigned short bf16;
typedef unsigned v4u __attribute__((ext_vector_type(4)));
typedef float f32x4 __attribute__((ext_vector_type(4)));
typedef short bf16x8 __attribute__((ext_vector_type(8)));
typedef GAS unsigned gu32;
typedef GAS unsigned long long gu64;
#define RLX_AGENT __ATOMIC_RELAXED, __HIP_MEMORY_SCOPE_AGENT
#define LDS_WAIT() asm volatile("s_waitcnt lgkmcnt(0)" ::: "memory")
#define VM_WAIT() asm volatile("s_waitcnt vmcnt(0)" ::: "memory")
__device__ __forceinline__ unsigned long long rt() { return __builtin_amdgcn_s_memrealtime(); }
__device__ __forceinline__ unsigned f2bf(float f) { unsigned u = __builtin_bit_cast(unsigned, f); return (u + 0x7fffu + ((u >> 16) & 1u)) >> 16; }
__device__ __forceinline__ unsigned pk2(float lo, float hi) { return f2bf(lo) | (f2bf(hi) << 16); }

#define XB_TMO      128
#define XB_XCNT(j)  (256  + 64 * (j))
#define XB_XSUB(j)  (1280 + 64 * (j))
#define XB_XGEN(j)  (2304 + 64 * (j))
#define XB_TOP      3328
#define XB_TOPGEN   3392
#define XCD_BAR_WORDS 3456
#define XB_SPIN_CAP (1u << 22)

__device__ __forceinline__ unsigned xb_ld(unsigned* p)              { return __hip_atomic_load(p, __ATOMIC_RELAXED, __HIP_MEMORY_SCOPE_AGENT); }
__device__ __forceinline__ unsigned xb_add(unsigned* p, unsigned v) { return __hip_atomic_fetch_add(p, v, __ATOMIC_RELAXED, __HIP_MEMORY_SCOPE_AGENT); }
__device__ __forceinline__ unsigned xb_xcc_id() { return (unsigned)__builtin_amdgcn_s_getreg((3 << 11) | 20) & 0xFu; }
#define XB_SPIN(cond, bar) do { unsigned _sp = 0; while (cond) { __builtin_amdgcn_s_sleep(1); \
    if ((++_sp & 255u) == 0u) { if (xb_ld(&(bar)[XB_TMO])) break; if (_sp > XB_SPIN_CAP) { atomicAdd(&(bar)[XB_TMO], 1u); break; } } } } while (0)

struct XcdBarrier {
    unsigned* bar; unsigned x;
    volatile LAS unsigned* st;
};

__device__ __forceinline__ XcdBarrier xcd_barrier_post(unsigned* bar, volatile LAS unsigned* st) {
    XcdBarrier b; b.bar = bar; b.x = xb_xcc_id(); b.st = st;
    if (threadIdx.x == 0) (void)xb_add(&bar[XB_XCNT(b.x)], 1u);
    return b;
}
__device__ __forceinline__ void xcd_barrier_complete(unsigned* bar, unsigned x, unsigned& nloc, unsigned& nx) {
    const unsigned G = gridDim.x * gridDim.y * gridDim.z;
    unsigned sum, cnt, mine, sp = 0u;
    for (;;) {
        sum = 0u; cnt = 0u; mine = 0u;
#pragma unroll
        for (unsigned j = 0; j < 16; ++j) { const unsigned c = xb_ld(&bar[XB_XCNT(j)]); sum += c; cnt += (c > 0u) ? 1u : 0u; mine = (j == x) ? c : mine; }
        if (sum == G) break;
        __builtin_amdgcn_s_sleep(1);
        if ((++sp & 255u) == 0u) { if (xb_ld(&bar[XB_TMO])) break; if (sp > XB_SPIN_CAP) { atomicAdd(&bar[XB_TMO], 1u); break; } }
    }
    nloc = mine > 0u ? mine : 1u; nx = cnt > 0u ? cnt : 1u;
}

__device__ __forceinline__ void xcd_barrier(const XcdBarrier& b) {
    asm volatile("s_waitcnt vmcnt(0)" ::: "memory");
    __syncthreads();
    if (threadIdx.x == 0) {
        unsigned* bar = b.bar;
        __builtin_amdgcn_s_waitcnt(0);
        unsigned nloc = b.st[0], nx = b.st[1];
        if (nloc == 0u) { xcd_barrier_complete(bar, b.x, nloc, nx); b.st[0] = nloc; b.st[1] = nx; }
        const unsigned old = xb_add(&bar[XB_XSUB(b.x)], 1u);
        const unsigned gen = old / nloc;
        if (old + 1u == (gen + 1u) * nloc) {
            __builtin_amdgcn_fence(__ATOMIC_RELEASE, "agent");
            asm volatile("s_waitcnt vmcnt(0)" ::: "memory");
            const unsigned og = xb_add(&bar[XB_TOP], 1u);
            const unsigned tg = og / nx;
            if (og + 1u == (tg + 1u) * nx) xb_add(&bar[XB_TOPGEN], 1u);
            else XB_SPIN(xb_ld(&bar[XB_TOPGEN]) == tg, bar);
            __builtin_amdgcn_fence(__ATOMIC_ACQUIRE, "agent");
            xb_add(&bar[XB_XGEN(b.x)], 1u);
            asm volatile("s_waitcnt vmcnt(0)" ::: "memory");
        } else {
            XB_SPIN(xb_ld(&bar[XB_XGEN(b.x)]) == gen, bar);
            __builtin_amdgcn_fence(__ATOMIC_ACQUIRE, "agent");
            asm volatile("s_waitcnt vmcnt(0)" ::: "memory");
        }
    }
    __syncthreads();
}


constexpr int NWAVES = 8;
constexpr int NB = 4, S = 8192, D = 1024, M = NB * S, FF = 4096;
constexpr int DIN = 2376, DINP = 2560;
constexpr int C_Q = 0, C_K = 512, C_V = 640, C_QI = 768, C_KI = 1280, C_WI = 1344, C_A = 1352, C_G = 1864;
constexpr int CONVK = 31, CCH = 512, MODW = 6 * D;
constexpr float EPS = 1e-6f;
constexpr float WI_SCALE = 0.04419417382415922f;
constexpr float SM_SCALE_LOG2E = 0.125f * 1.4426950408889634f;

constexpr size_t MiB = 1u << 20;
constexpr size_t WS_CTL = 0, CTL_ZERO_BYTES = 1 * MiB;
constexpr size_t WS_WIN = 1 * MiB, WS_WOUT = 6 * MiB, WS_WUP = 8 * MiB, WS_WDN = 16 * MiB;
constexpr size_t WS_MOD = 24 * MiB, WS_CS = 25 * MiB;
constexpr size_t WS_H = 32 * MiB;
constexpr size_t WS_PROJ = 96 * MiB;
constexpr size_t WS_Q = 256 * MiB, WS_K = 288 * MiB, WS_V = 296 * MiB, WS_QI = 304 * MiB, WS_KI = 336 * MiB, WS_WI = 340 * MiB, WS_GLU = 344 * MiB;
constexpr size_t WS_MIX = 376 * MiB;
constexpr size_t WS_U = 96 * MiB;
constexpr size_t WS_END = 440 * MiB;
constexpr int CW_BAR = 4096;

constexpr int RING_OFF = 0, RING_BYTES = 131072;
constexpr int LDSCTL_OFF = RING_BYTES, MISC_OFF = LDSCTL_OFF + 320;
constexpr int LDS_BYTES = 147456;

struct Frame {
    LAS unsigned char* lds;
    volatile LAS unsigned* MISC;
    gu32* ctl;
    int tid, lane, wave;
    int vcu, G;
    const float *x, *c, *w_ada, *b_ada, *g_mix, *w_in, *conv_w, *conv_b, *conv_ng, *conv_nb, *w_out, *g_mlp, *w_up, *w_down, *g_final;
    const int* positions;
    float* out;
    bf16 *Win_t, *Wout_t, *Wup_t, *Wdn_t;
    float *mod, *CS, *WI;
    bf16 *H, *PROJ, *Q, *K, *V, *QI, *KI, *GLU, *MIX, *U;
};

__device__ __forceinline__ float wave_sum(float v) {
#pragma unroll
    for (int o = 1; o < 64; o <<= 1) v += __shfl_xor(v, o);
    return v;
}
__device__ __forceinline__ float bf2f(unsigned u16) { return __uint_as_float(u16 << 16); }

__device__ __forceinline__ void p0_transpose_item(const float* W, int K, int N, int Npad, bf16* WT, LAS float* scr, int item, int lane) {
    const int nblk = Npad / 32, kb = item / nblk, nb = item % nblk, k0 = 64 * kb, n0 = 32 * nb;
    const int ncol = n0 + (lane & 31); const bool ok = ncol < N;
#pragma unroll 8
    for (int i = 0; i < 32; ++i) { const int kk = 2 * i + (lane >> 5); scr[kk * 33 + (lane & 31)] = ok ? W[(size_t)(k0 + kk) * N + ncol] : 0.f; }
    LDS_WAIT(); asm volatile("" ::: "memory");
    const int c = lane & 7;
#pragma unroll
    for (int j = 0; j < 4; ++j) { const int n = (lane >> 3) + 8 * j; const LAS float* s = scr + (8 * c) * 33 + n;
        v4u o; o.x = pk2(s[0 * 33], s[1 * 33]); o.y = pk2(s[2 * 33], s[3 * 33]); o.z = pk2(s[4 * 33], s[5 * 33]); o.w = pk2(s[6 * 33], s[7 * 33]);
        *(GAS v4u*)(WT + (size_t)(n0 + n) * K + k0 + 8 * c) = o; }
    LDS_WAIT(); asm volatile("" ::: "memory");
}

__device__ __forceinline__ void p0_prologue(Frame& F) {
    LAS float* cond = (LAS float*)(F.lds + 73728);
    for (int i = F.tid; i < NB * D; i += NWAVES * 64) { const float v = F.c[i]; cond[i] = v / (1.f + expf(-v)); }
    __syncthreads();
    const int gw = F.vcu * NWAVES + F.wave, NGW = F.G * NWAVES, lane = F.lane;
    for (int it = gw; it < MODW / 16; it += NGW) {
        const int col = it * 16 + (lane & 15), kg = lane >> 4;
        float a0 = 0.f, a1 = 0.f, a2 = 0.f, a3 = 0.f;
        const float* wp = F.w_ada + (size_t)kg * MODW + col;
#pragma unroll 16
        for (int i = 0; i < D / 4; ++i) { const int k = kg + 4 * i; const float w = wp[(size_t)i * 4 * MODW];
            a0 += w * cond[k]; a1 += w * cond[D + k]; a2 += w * cond[2 * D + k]; a3 += w * cond[3 * D + k]; }
        a0 += __shfl_xor(a0, 16); a0 += __shfl_xor(a0, 32); a1 += __shfl_xor(a1, 16); a1 += __shfl_xor(a1, 32);
        a2 += __shfl_xor(a2, 16); a2 += __shfl_xor(a2, 32); a3 += __shfl_xor(a3, 16); a3 += __shfl_xor(a3, 32);
        if (lane < 16) { const float bb = F.b_ada[col]; F.mod[col] = a0 + bb; F.mod[MODW + col] = a1 + bb; F.mod[2 * MODW + col] = a2 + bb; F.mod[3 * MODW + col] = a3 + bb; }
    }
    LAS float* scr = (LAS float*)(F.lds + F.wave * 8448);
    constexpr int I_IN = (D / 64) * (DINP / 32), I_OUT = (D / 64) * (D / 32), I_UP = (D / 64) * (FF / 32), I_DN = (FF / 64) * (D / 32);
    constexpr int NITEMS = I_IN + I_OUT + I_UP + I_DN;
    for (int it = gw; it < NITEMS; it += NGW) {
        int r = it;
        if (r < I_IN) { p0_transpose_item(F.w_in, D, DIN, DINP, F.Win_t, scr, r, lane); continue; } r -= I_IN;
        if (r < I_OUT) { p0_transpose_item(F.w_out, D, D, D, F.Wout_t, scr, r, lane); continue; } r -= I_OUT;
        if (r < I_UP) { p0_transpose_item(F.w_up, D, FF, FF, F.Wup_t, scr, r, lane); continue; } r -= I_UP;
        p0_transpose_item(F.w_down, FF, D, D, F.Wdn_t, scr, r, lane);
    }
    for (int i = gw * 64 + lane; i < M * 8; i += NGW * 64) {
        const int m = i >> 3, f = i & 7;
        const float invf = (f == 0) ? 1.0f : (f == 1) ? 0.1939227432012558f : (f == 2) ? 0.03760603070259094f : (f == 3) ? 0.007292664609849453f
                         : (f == 4) ? 0.0014142135623842478f : (f == 5) ? 0.00027424818836152554f : (f == 6) ? 5.3182957344688475e-05f : 1.0313385246263351e-05f;
        const float ang = (float)F.positions[m] * invf;
        const double a = (double)ang, q = rint(a * 0.63661977236758134308), rr = a - q * 1.57079632679489661923, r2 = rr * rr;
        const int n = (int)q;
        const double sn = rr * (1.0 + r2 * (-1.0 / 6 + r2 * (1.0 / 120 + r2 * (-1.0 / 5040 + r2 * (1.0 / 362880 + r2 * (-1.0 / 39916800 + r2 * (1.0 / 6227020800.0)))))));
        const double cs = 1.0 + r2 * (-0.5 + r2 * (1.0 / 24 + r2 * (-1.0 / 720 + r2 * (1.0 / 40320 + r2 * (-1.0 / 3628800 + r2 * (1.0 / 479001600 + r2 * (-1.0 / 87178291200.0)))))));
        double so, co;
        switch (n & 3) { case 0: so = sn; co = cs; break; case 1: so = cs; co = -sn; break; case 2: so = -sn; co = -cs; break; default: so = -cs; co = sn; break; }
        F.CS[(size_t)m * 16 + f] = (float)co; F.CS[(size_t)m * 16 + 8 + f] = (float)so;
    }
}

__device__ __forceinline__ void normmod_rows(Frame& F, const float* X, const float* g, const float* sh, const float* sc, bf16* out) {
    const int gw = F.vcu * NWAVES + F.wave, NGW = F.G * NWAVES, lane = F.lane;
    for (int blk = gw; blk < M / 16; blk += NGW) {
        const int r0 = blk * 16, b = r0 / S;
        f32x4 A[4], Bv[4];
#pragma unroll
        for (int j = 0; j < 4; ++j) { const int c = 4 * lane + 256 * j; const f32x4 gg = *(const f32x4*)(g + c), s1 = *(const f32x4*)(sc + (size_t)b * MODW + c);
            A[j] = gg * (s1 + 1.0f); Bv[j] = *(const f32x4*)(sh + (size_t)b * MODW + c); }
        for (int r = 0; r < 16; ++r) {
            const GAS f32x4* xr = (const GAS f32x4*)(X + (size_t)(r0 + r) * D) + lane;
            f32x4 v[4]; float ss = 0.f;
#pragma unroll
            for (int j = 0; j < 4; ++j) { v[j] = xr[64 * j]; ss += (v[j].x * v[j].x + v[j].y * v[j].y) + (v[j].z * v[j].z + v[j].w * v[j].w); }
            const float rinv = 1.0f / sqrtf(wave_sum(ss) * (1.0f / D) + EPS);
            GAS unsigned long long* o8 = (GAS unsigned long long*)(out + (size_t)(r0 + r) * D) + lane;
#pragma unroll
            for (int j = 0; j < 4; ++j) { const f32x4 y = v[j] * rinv * A[j] + Bv[j];
                o8[64 * j] = (unsigned long long)pk2(y.x, y.y) | ((unsigned long long)pk2(y.z, y.w) << 32); }
        }
    }
}
__device__ __forceinline__ void final_norm_rows(Frame& F, float* X, const float* g) {
    const int gw = F.vcu * NWAVES + F.wave, NGW = F.G * NWAVES, lane = F.lane;
    f32x4 A[4];
#pragma unroll
    for (int j = 0; j < 4; ++j) A[j] = *(const f32x4*)(g + 4 * lane + 256 * j);
    for (int blk = gw; blk < M / 16; blk += NGW) {
        for (int r = 0; r < 16; ++r) {
            GAS f32x4* xr = (GAS f32x4*)(X + (size_t)(blk * 16 + r) * D) + lane;
            f32x4 v[4]; float ss = 0.f;
#pragma unroll
            for (int j = 0; j < 4; ++j) { v[j] = xr[64 * j]; ss += (v[j].x * v[j].x + v[j].y * v[j].y) + (v[j].z * v[j].z + v[j].w * v[j].w); }
            const float rinv = 1.0f / sqrtf(wave_sum(ss) * (1.0f / D) + EPS);
#pragma unroll
            for (int j = 0; j < 4; ++j) xr[64 * j] = v[j] * rinv * A[j];
        }
    }
}

__device__ __forceinline__ void p3_post(Frame& F) {
    const int gw = F.vcu * NWAVES + F.wave, NGW = F.G * NWAVES, lane = F.lane;
    const int l31 = lane & 31; const bool rot = l31 < 8, isx1 = l31 < 4; const int i0 = 2 * (lane & 3);
    for (int blk = gw; blk < M / 16; blk += NGW) {
        for (int r = 0; r < 16; ++r) {
            const size_t m = (size_t)blk * 16 + r;
            const bf16* pr = F.PROJ + m * DINP;
            const float c0 = F.CS[m * 16 + i0], c1 = F.CS[m * 16 + i0 + 1], s0 = F.CS[m * 16 + 8 + i0], s1 = F.CS[m * 16 + 8 + i0 + 1];
#pragma unroll
            for (int j = 0; j < 11; ++j) {
                const unsigned u = *(const unsigned*)(pr + 128 * j + 2 * lane);
                float v0 = bf2f(u & 0xffffu), v1 = bf2f(u >> 16);
                if (j != 5) {
                    const float p0 = __shfl_xor(v0, 4), p1 = __shfl_xor(v1, 4);
                    if (rot && !(j == 10 && lane >= 32)) {
                        if (isx1) { v0 = v0 * c0 - p0 * s0; v1 = v1 * c1 - p1 * s1; } else { v0 = v0 * c0 + p0 * s0; v1 = v1 * c1 + p1 * s1; }
                    }
                }
                const unsigned w = pk2(v0, v1);
                if (j < 4) *(unsigned*)(F.Q + m * 512 + 128 * j + 2 * lane) = w;
                else if (j == 4) *(unsigned*)(F.K + m * 128 + 2 * lane) = w;
                else if (j == 5) *(unsigned*)(F.V + m * 128 + 2 * lane) = w;
                else if (j < 10) *(unsigned*)(F.QI + m * 512 + 128 * (j - 6) + 2 * lane) = w;
                else { if (lane < 32) *(unsigned*)(F.KI + m * 64 + 2 * lane) = w;
                       else if (lane < 36) { F.WI[m * 8 + 2 * (lane - 32)] = v0 * WI_SCALE; F.WI[m * 8 + 2 * (lane - 32) + 1] = v1 * WI_SCALE; } }
            }
#pragma unroll
            for (int j = 0; j < 4; ++j) {
                const int ch = 128 * j + 2 * lane;
                const unsigned ua = *(const unsigned*)(pr + C_A + ch), ug = *(const unsigned*)(pr + C_G + ch);
                const float a0 = bf2f(ua & 0xffffu), a1 = bf2f(ua >> 16), g0 = bf2f(ug & 0xffffu), g1 = bf2f(ug >> 16);
                *(unsigned*)(F.GLU + m * CCH + ch) = pk2(a0 / (1.f + __expf(-g0)), a1 / (1.f + __expf(-g1)));
            }
        }
    }
}

__device__ __forceinline__ void p4_conv(Frame& F) {
    LAS f32x4* wl = (LAS f32x4*)(F.lds);
    LAS unsigned char* inl = F.lds + 63488;
    const int lane = F.lane;
    for (int i = F.tid; i < CONVK * CCH; i += NWAVES * 64) { const int j = i / CCH, ch = i % CCH;
        ((LAS float*)wl)[((j * 2 + ((ch >> 2) & 1)) * 64 + (ch >> 3)) * 4 + (ch & 3)] = F.conv_w[i]; }
    f32x4 cb[2], ng[2], nb[2];
#pragma unroll
    for (int h = 0; h < 2; ++h) { cb[h] = *(const f32x4*)(F.conv_b + 8 * lane + 4 * h); ng[h] = *(const f32x4*)(F.conv_ng + 8 * lane + 4 * h); nb[h] = *(const f32x4*)(F.conv_nb + 8 * lane + 4 * h); }
    for (int tile = F.vcu; tile < M / 32; tile += F.G) {
        __syncthreads();
        const int m0 = tile * 32, s0 = m0 & (S - 1);
        for (int i = F.tid; i < 62 * 64; i += NWAVES * 64) { const int r = i >> 6, cc = i & 63;
            v4u v = (v4u){0u, 0u, 0u, 0u};
            if (s0 - 30 + r >= 0) v = *(const v4u*)(F.GLU + (size_t)(m0 - 30 + r) * CCH + cc * 8);
            *(LAS v4u*)(inl + r * 1024 + cc * 16) = v; }
        __syncthreads();
        for (int tt = 0; tt < 4; ++tt) {
            const int tl = F.wave * 4 + tt;
            f32x4 a0 = cb[0], a1 = cb[1];
#pragma unroll 2
            for (int j = 0; j < CONVK; ++j) {
                const v4u in = *(const LAS v4u*)(inl + (tl + j) * 1024 + lane * 16);
                const f32x4 w0 = wl[(j * 2 + 0) * 64 + lane], w1 = wl[(j * 2 + 1) * 64 + lane];
                const f32x4 x0 = (f32x4){bf2f(in.x & 0xffffu), bf2f(in.x >> 16), bf2f(in.y & 0xffffu), bf2f(in.y >> 16)};
                const f32x4 x1 = (f32x4){bf2f(in.z & 0xffffu), bf2f(in.z >> 16), bf2f(in.w & 0xffffu), bf2f(in.w >> 16)};
                a0 += w0 * x0; a1 += w1 * x1;
            }
            const float mean = wave_sum((a0.x + a0.y) + (a0.z + a0.w) + (a1.x + a1.y) + (a1.z + a1.w)) * (1.0f / CCH);
            a0 = a0 - mean; a1 = a1 - mean;
            const float var = wave_sum((a0.x * a0.x + a0.y * a0.y) + (a0.z * a0.z + a0.w * a0.w) + (a1.x * a1.x + a1.y * a1.y) + (a1.z * a1.z + a1.w * a1.w)) * (1.0f / CCH);
            const float rstd = 1.0f / sqrtf(var + EPS);
            f32x4 y0 = a0 * rstd * ng[0] + nb[0], y1 = a1 * rstd * ng[1] + nb[1];
            y0 = (f32x4){y0.x / (1.f + __expf(-y0.x)), y0.y / (1.f + __expf(-y0.y)), y0.z / (1.f + __expf(-y0.z)), y0.w / (1.f + __expf(-y0.w))};
            y1 = (f32x4){y1.x / (1.f + __expf(-y1.x)), y1.y / (1.f + __expf(-y1.y)), y1.z / (1.f + __expf(-y1.z)), y1.w / (1.f + __expf(-y1.w))};
            v4u o; o.x = pk2(y0.x, y0.y); o.y = pk2(y0.z, y0.w); o.z = pk2(y1.x, y1.y); o.w = pk2(y1.z, y1.w);
            *(GAS v4u*)(F.MIX + (size_t)(m0 + tl) * D + CCH + 8 * lane) = o;
        }
    }
    __syncthreads();
}

constexpr int DC = 768, DNR = DC / 64, TOPK = 256, DSLACK = 64;
typedef float f32x16 __attribute__((ext_vector_type(16)));
typedef float f32x2 __attribute__((ext_vector_type(2)));
__device__ __forceinline__ unsigned ordkey(float s, int key) {
    unsigned u = __float_as_uint(s); u ^= (unsigned)((int)u >> 31) | 0x80000000u;
    return (u & 0xFFFFE000u) | (unsigned)(8191 - key);
}
__device__ __forceinline__ int mbcnt64(unsigned long long mk) { return (int)__builtin_amdgcn_mbcnt_hi((unsigned)(mk >> 32), __builtin_amdgcn_mbcnt_lo((unsigned)mk, 0u)); }
template <int SLACK>
__device__ __forceinline__ int dsa_compact(LAS unsigned* buf, int cnt, int lane, unsigned& tau) {
    unsigned e[DNR]; unsigned mxl = 0u;
#pragma unroll
    for (int i = 0; i < DNR; ++i) { const int idx = i * 64 + lane; e[i] = idx < cnt ? buf[idx] : 0u; mxl = mxl > e[i] ? mxl : e[i]; }
#pragma unroll
    for (int o = 1; o < 64; o <<= 1) { const unsigned other = (unsigned)__shfl_xor((int)mxl, o); mxl = mxl > other ? mxl : other; }
    unsigned lo = tau, hi = (unsigned)__builtin_amdgcn_readfirstlane((int)mxl) + 1u, thr; int c;
#pragma unroll 1
    for (;;) {
        const unsigned mid = lo + ((hi - lo) >> 1); c = 0;
#pragma unroll
        for (int i = 0; i < DNR; ++i) c += __popcll(__ballot(e[i] >= mid));
        if (c < TOPK) hi = mid; else if (c > TOPK + SLACK) lo = mid; else { thr = mid; break; }
    }
    int base = 0;
#pragma unroll
    for (int i = 0; i < DNR; ++i) { const bool k = e[i] >= thr; const unsigned long long mk = __ballot(k); const int pos = base + mbcnt64(mk); if (k) buf[pos] = e[i]; base += __popcll(mk); }
    tau = thr; return base;
}

__device__ __forceinline__ void dsa_unit(Frame& F, int lane, int b, int t0, LAS unsigned* cw) {
    const int r = lane & 31, hi = lane >> 5;
    const size_t mb = (size_t)b * S;
    const int a_ = r >> 2, i_ = r & 3, ql = ((a_ >> 2) & 1) + 2 * (a_ & 1), hd = 4 * ((a_ >> 1) & 1) + i_;
    const bf16* qip = F.QI + (mb + t0 + ql) * 512 + hd * 64 + hi * 8;
    bf16x8 A[4];
#pragma unroll
    for (int ks = 0; ks < 4; ++ks) A[ks] = *(const bf16x8*)(qip + ks * 16);
    f32x2 wv[8];
    { const f32x2* wp = (const f32x2*)(F.WI + (mb + t0 + 2 * hi) * 8);
#pragma unroll
      for (int q2 = 0; q2 < 8; ++q2) wv[q2] = wp[q2]; }
    const int tA = t0 + 2 * hi, tB = tA + 1;
    int cnt0 = 0, cnt1 = 0, cnt2 = 0, cnt3 = 0; unsigned tau0 = 0u, tau1 = 0u, tau2 = 0u, tau3 = 0u;
    const bf16* kip = F.KI + (mb + r) * 64 + hi * 8;
    const int nit = ((t0 + 3) >> 6) + 1;
#define DSA_APPEND(pred, pk, cntL, cntH, qL, qH) do { const unsigned long long mk_ = __ballot(pred); const unsigned lo_ = (unsigned)mk_, hh_ = (unsigned)(mk_ >> 32); \
        const int pos_ = hi ? (cntH + (int)__builtin_amdgcn_mbcnt_hi(hh_, 0u)) : (cntL + (int)__builtin_amdgcn_mbcnt_lo(lo_, 0u)); \
        if (pred) cw[(hi ? (qH) : (qL)) * DC + pos_] = (pk); cntL += __popc(lo_); cntH += __popc(hh_); } while (0)
#define DSA_SUBTILE(B0, B1, B2, B3, s0_) do { \
        f32x16 acc = {0.f, 0.f, 0.f, 0.f, 0.f, 0.f, 0.f, 0.f, 0.f, 0.f, 0.f, 0.f, 0.f, 0.f, 0.f, 0.f}; \
        acc = __builtin_amdgcn_mfma_f32_32x32x16_bf16(A[0], B0, acc, 0, 0, 0); acc = __builtin_amdgcn_mfma_f32_32x32x16_bf16(A[1], B1, acc, 0, 0, 0); \
        acc = __builtin_amdgcn_mfma_f32_32x32x16_bf16(A[2], B2, acc, 0, 0, 0); acc = __builtin_amdgcn_mfma_f32_32x32x16_bf16(A[3], B3, acc, 0, 0, 0); \
        f32x2 sa = {0.f, 0.f}, sb = {0.f, 0.f}; \
        _Pragma("unroll") for (int g = 0; g < 4; ++g) { sa += wv[g] * (f32x2){fmaxf(acc[2 * g], 0.f), fmaxf(acc[2 * g + 1], 0.f)}; sb += wv[4 + g] * (f32x2){fmaxf(acc[8 + 2 * g], 0.f), fmaxf(acc[9 + 2 * g], 0.f)}; } \
        const float sc0 = sa.x + sa.y, sc1 = sb.x + sb.y; \
        const int key = (s0_) + r; \
        const unsigned pk0 = ordkey(sc0, key), pk1 = ordkey(sc1, key); \
        const unsigned tauA = hi ? tau2 : tau0, tauB = hi ? tau3 : tau1; \
        const bool p0 = (key <= tA) && (pk0 > tauA), p1 = (key <= tB) && (pk1 > tauB); \
        DSA_APPEND(p0, pk0, cnt0, cnt2, 0, 2); \
        DSA_APPEND(p1, pk1, cnt1, cnt3, 1, 3); \
        if (cnt0 > DC - 32) cnt0 = dsa_compact<DSLACK>(cw + 0 * DC, cnt0, lane, tau0); \
        if (cnt1 > DC - 32) cnt1 = dsa_compact<DSLACK>(cw + 1 * DC, cnt1, lane, tau1); \
        if (cnt2 > DC - 32) cnt2 = dsa_compact<DSLACK>(cw + 2 * DC, cnt2, lane, tau2); \
        if (cnt3 > DC - 32) cnt3 = dsa_compact<DSLACK>(cw + 3 * DC, cnt3, lane, tau3); } while (0)
    bf16x8 Bc[8];
#pragma unroll
    for (int k = 0; k < 8; ++k) Bc[k] = *(const bf16x8*)(kip + (size_t)(k >> 2) * 32 * 64 + (k & 3) * 16);
#pragma unroll 1
    for (int it = 0; it < nit; ++it) {
        bf16x8 Bn[8];
        const bf16* kn = kip + (size_t)(it + 1 < nit ? it + 1 : it) * 64 * 64;
#pragma unroll
        for (int k = 0; k < 8; ++k) Bn[k] = *(const bf16x8*)(kn + (size_t)(k >> 2) * 32 * 64 + (k & 3) * 16);
        DSA_SUBTILE(Bc[0], Bc[1], Bc[2], Bc[3], it * 64);
        DSA_SUBTILE(Bc[4], Bc[5], Bc[6], Bc[7], it * 64 + 32);
#pragma unroll
        for (int k = 0; k < 8; ++k) Bc[k] = Bn[k];
    }
#undef DSA_SUBTILE
#undef DSA_APPEND
    if (cnt0 > TOPK) cnt0 = dsa_compact<0>(cw + 0 * DC, cnt0, lane, tau0);
    if (cnt1 > TOPK) cnt1 = dsa_compact<0>(cw + 1 * DC, cnt1, lane, tau1);
    if (cnt2 > TOPK) cnt2 = dsa_compact<0>(cw + 2 * DC, cnt2, lane, tau2);
    if (cnt3 > TOPK) cnt3 = dsa_compact<0>(cw + 3 * DC, cnt3, lane, tau3);
    const int fr = lane & 15, fq = lane >> 4;
#pragma unroll 1
    for (int q = 0; q < 4; ++q) {
        const int nsel = (q == 0) ? cnt0 : (q == 1) ? cnt1 : (q == 2) ? cnt2 : cnt3;
        const int t = t0 + q;
        const LAS unsigned* sel = cw + q * DC;
        bf16x8 Bq[4];
#pragma unroll
        for (int ks = 0; ks < 4; ++ks) { const bool ok = (fr < 8) && ((fr >> 2) == (ks >> 1));
            bf16x8 v = {0, 0, 0, 0, 0, 0, 0, 0};
            if (ok) v = *(const bf16x8*)(F.Q + (mb + t) * 512 + fr * 64 + (ks & 1) * 32 + fq * 8);
            Bq[ks] = v; }
        f32x4 lg[16];
        const LAS unsigned* selq = sel + fr;
#pragma unroll
        for (int T4 = 0; T4 < 16; T4 += 4) {
            bf16x8 kf[4][4];
#pragma unroll
            for (int tt = 0; tt < 4; ++tt) {
                const int sidx = (16 * (T4 + tt) < nsel - fr) ? (8191 - (int)(selq[16 * (T4 + tt)] & 0x1FFFu)) : 0;
                const bf16* kp = F.K + (mb + sidx) * 128 + fq * 8;
#pragma unroll
                for (int ks = 0; ks < 4; ++ks) kf[tt][ks] = *(const bf16x8*)(kp + ks * 32); }
#pragma unroll
            for (int tt = 0; tt < 4; ++tt) { f32x4 a4 = {0.f, 0.f, 0.f, 0.f};
#pragma unroll
                for (int ks = 0; ks < 4; ++ks) a4 = __builtin_amdgcn_mfma_f32_16x16x32_bf16(kf[tt][ks], Bq[ks], a4, 0, 0, 0);
                lg[T4 + tt] = a4; }
            asm volatile("" ::: "memory");
        }
        float mx = -INFINITY; const int nsq = nsel - 4 * fq;
#pragma unroll
        for (int T = 0; T < 16; ++T)
#pragma unroll
            for (int g = 0; g < 4; ++g) { const float xv = (16 * T + g < nsq) ? lg[T][g] * SM_SCALE_LOG2E : -INFINITY; lg[T][g] = xv; mx = fmaxf(mx, xv); }
        mx = fmaxf(mx, __shfl_xor(mx, 16)); mx = fmaxf(mx, __shfl_xor(mx, 32));
        float sm = 0.f;
#pragma unroll
        for (int T = 0; T < 16; ++T)
#pragma unroll
            for (int g = 0; g < 4; ++g) { const float p = __builtin_amdgcn_exp2f(lg[T][g] - mx); lg[T][g] = p; sm += p; }
        sm += __shfl_xor(sm, 16); sm += __shfl_xor(sm, 32);
        const float inv = 1.0f / sm;
        if (fr < 8) {
            LAS float* pwr = (LAS float*)cw + 32 * fq + fr;
#pragma unroll
            for (int T = 0; T < 16; ++T)
#pragma unroll
                for (int g = 0; g < 4; ++g) pwr[(T >> 2) * DC + 256 + (16 * (T & 3) + g) * 8] = lg[T][g] * inv;
        }
        const int g4 = fq, ch = fr, kh = ch >> 3;
        f32x2 oa[4][4];
#pragma unroll
        for (int h = 0; h < 4; ++h)
#pragma unroll
            for (int dp = 0; dp < 4; ++dp) oa[h][dp] = (f32x2){0.f, 0.f};
        const bf16* vb = F.V + mb * 128 + 8 * ch;
#pragma unroll 1
        for (int i0 = 0; i0 < 64; i0 += 16) {
            const LAS unsigned* selp = sel + 4 * i0 + g4;
            const LAS float* prd = (const LAS float*)cw + (i0 >> 4) * DC + 8 * g4 + 4 * kh;
            const int nrem = nsel - 4 * i0 - g4;
            v4u vv[16];
#pragma unroll
            for (int k = 0; k < 16; ++k) { const int sidx = (4 * k < nrem) ? (8191 - (int)(selp[4 * k] & 0x1FFFu)) : 0; vv[k] = *(const v4u*)(vb + (size_t)sidx * 128); }
#pragma unroll
            for (int k = 0; k < 16; ++k) {
                const f32x4 p = *(const LAS f32x4*)(prd + 256 + 32 * k);
                const f32x2 x0 = (f32x2){bf2f(vv[k].x & 0xffffu), __uint_as_float(vv[k].x & 0xffff0000u)}, x1 = (f32x2){bf2f(vv[k].y & 0xffffu), __uint_as_float(vv[k].y & 0xffff0000u)};
                const f32x2 x2 = (f32x2){bf2f(vv[k].z & 0xffffu), __uint_as_float(vv[k].z & 0xffff0000u)}, x3 = (f32x2){bf2f(vv[k].w & 0xffffu), __uint_as_float(vv[k].w & 0xffff0000u)};
#pragma unroll
                for (int h = 0; h < 4; ++h) { const f32x2 ph = (f32x2){p[h], p[h]}; oa[h][0] += ph * x0; oa[h][1] += ph * x1; oa[h][2] += ph * x2; oa[h][3] += ph * x3; } }
        }
#pragma unroll
        for (int h = 0; h < 4; ++h)
#pragma unroll
            for (int dp = 0; dp < 4; ++dp) { float a = oa[h][dp].x, c2 = oa[h][dp].y; a += __shfl_xor(a, 16); a += __shfl_xor(a, 32); c2 += __shfl_xor(c2, 16); c2 += __shfl_xor(c2, 32); oa[h][dp] = (f32x2){a, c2}; }
        if (lane < 16) {
            bf16* op = F.MIX + (mb + t) * D + (kh * 4) * 64 + 8 * (ch & 7);
#pragma unroll
            for (int h = 0; h < 4; ++h) { v4u o; o.x = pk2(oa[h][0].x, oa[h][0].y); o.y = pk2(oa[h][1].x, oa[h][1].y); o.z = pk2(oa[h][2].x, oa[h][2].y); o.w = pk2(oa[h][3].x, oa[h][3].y);
                *(v4u*)(op + h * 64) = o; }
        }
    }
}
__device__ __forceinline__ void p4_dsa(Frame& F) {
    LAS unsigned* cw = (LAS unsigned*)(F.lds + F.wave * (DC * 16));
    int lane = threadIdx.x & 63; asm volatile("" : "+v"(lane));
    const int gw = F.vcu * NWAVES + F.wave, NGW = F.G * NWAVES;
    for (int w = gw; w < 2048; w += NGW) {
        const int b = w >> 9, j = w & 511;
#pragma unroll 1
        for (int k = 0; k < 4; ++k) { const int u = (k == 0) ? j : (k == 1) ? 1023 - j : (k == 2) ? 1024 + j : 2047 - j; dsa_unit(F, lane, b, 4 * u, cw); }
    }
}

struct Args { const void* in[16]; float* out; unsigned char* ws; };
__global__ void __launch_bounds__(NWAVES * 64, 2) fwd_kernel(Args args) {
    extern __shared__ __attribute__((aligned(16))) unsigned char lds[];
    Frame F;
    F.lds = (LAS unsigned char*)lds;
    F.MISC = (volatile LAS unsigned*)(F.lds + MISC_OFF);
    F.tid = threadIdx.x; F.lane = F.tid & 63; F.wave = __builtin_amdgcn_readfirstlane(F.tid >> 6);
    F.G = gridDim.x; { const int bx = blockIdx.x; F.vcu = (F.G % 8 == 0) ? (bx % 8) * (F.G / 8) + bx / 8 : bx; }
    unsigned char* ws = args.ws;
    F.ctl = (gu32*)(ws + WS_CTL);
    F.x = (const float*)args.in[0]; F.c = (const float*)args.in[1]; F.positions = (const int*)args.in[2]; F.w_ada = (const float*)args.in[3]; F.b_ada = (const float*)args.in[4];
    F.g_mix = (const float*)args.in[5]; F.w_in = (const float*)args.in[6]; F.conv_w = (const float*)args.in[7]; F.conv_b = (const float*)args.in[8]; F.conv_ng = (const float*)args.in[9];
    F.conv_nb = (const float*)args.in[10]; F.w_out = (const float*)args.in[11]; F.g_mlp = (const float*)args.in[12]; F.w_up = (const float*)args.in[13]; F.w_down = (const float*)args.in[14];
    F.g_final = (const float*)args.in[15]; F.out = args.out;
    F.Win_t = (bf16*)(ws + WS_WIN); F.Wout_t = (bf16*)(ws + WS_WOUT); F.Wup_t = (bf16*)(ws + WS_WUP); F.Wdn_t = (bf16*)(ws + WS_WDN);
    F.mod = (float*)(ws + WS_MOD); F.CS = (float*)(ws + WS_CS); F.WI = (float*)(ws + WS_WI);
    F.H = (bf16*)(ws + WS_H); F.PROJ = (bf16*)(ws + WS_PROJ); F.Q = (bf16*)(ws + WS_Q); F.K = (bf16*)(ws + WS_K); F.V = (bf16*)(ws + WS_V); F.QI = (bf16*)(ws + WS_QI);
    F.KI = (bf16*)(ws + WS_KI); F.GLU = (bf16*)(ws + WS_GLU); F.MIX = (bf16*)(ws + WS_MIX); F.U = (bf16*)(ws + WS_U);
    for (int u = F.tid; u < (LDS_BYTES - LDSCTL_OFF) / 4; u += NWAVES * 64) ((LAS unsigned*)(F.lds + LDSCTL_OFF))[u] = 0u;
    __syncthreads();
    XcdBarrier bar = xcd_barrier_post((unsigned*)(F.ctl + CW_BAR), F.MISC + 8);
#define GRID_BAR() xcd_barrier(bar)
    const float* sh1 = F.mod, *sc1 = F.mod + D, *gt1 = F.mod + 2 * D, *sh2 = F.mod + 3 * D, *sc2 = F.mod + 4 * D, *gt2 = F.mod + 5 * D;

    p0_prologue(F); GRID_BAR();
    normmod_rows(F, F.x, F.g_mix, sh1, sc1, F.H); GRID_BAR();
    { pg8::Gemm g{F.H, F.Win_t, M, DINP, D}; pg8::StaticOrder So; So.init(M, DINP, F.G, (int)blockIdx.x);
      pg8::EpiBf16<0> E{F.PROJ, DINP, nullptr, 0, 0, 1.f};
      pg8::gemm_phase<pg8::EpiBf16<0>, pg8::StaticOrder, true, true>(F.lds + RING_OFF, g, So, E); }
    GRID_BAR();
    p3_post(F); GRID_BAR();
    p4_conv(F); p4_dsa(F); GRID_BAR();
    { pg8::Gemm g{F.MIX, F.Wout_t, M, D, D}; pg8::StaticOrder So; So.init(M, D, F.G, (int)blockIdx.x);
      pg8::EpiResGate E{F.x, F.out, D, gt1, MODW, S};
      pg8::gemm_phase<pg8::EpiResGate, pg8::StaticOrder, true, true>(F.lds + RING_OFF, g, So, E); }
    GRID_BAR();
    normmod_rows(F, F.out, F.g_mlp, sh2, sc2, F.H); GRID_BAR();
    { pg8::Gemm g{F.H, F.Wup_t, M, FF, D}; pg8::StaticOrder So; So.init(M, FF, F.G, (int)blockIdx.x);
      pg8::EpiBf16<2> E{F.U, FF, nullptr, 0, 0, 1.f};
      pg8::gemm_phase<pg8::EpiBf16<2>, pg8::StaticOrder, true, true>(F.lds + RING_OFF, g, So, E); }
    GRID_BAR();
    { pg8::Gemm g{F.U, F.Wdn_t, M, D, FF}; pg8::StaticOrder So; So.init(M, D, F.G, (int)blockIdx.x);
      pg8::EpiResGate E{F.out, F.out, D, gt2, MODW, S};
      pg8::gemm_phase<pg8::EpiResGate, pg8::StaticOrder, true, true>(F.lds + RING_OFF, g, So, E); }
    GRID_BAR();
    final_norm_rows(F, F.out, F.g_final);
#undef GRID_BAR
}

extern "C" void kernel_launch(void* const* d_in, const int* in_sizes, int n_in, void* d_out, int out_size, void* d_ws, size_t ws_size, hipStream_t stream) {
    static int grid = 0;
    if (grid == 0) {
        if (n_in != 16 || in_sizes[0] != M * D || out_size != M * D || ws_size < WS_END) { fprintf(stderr, "kernel_launch: unexpected shapes (n_in %d, in0 %d, out %d, ws %zu); nothing launched\n", n_in, n_in > 0 ? in_sizes[0] : -1, out_size, ws_size); grid = -1; return; }
        int dev = 0, cus = 0, per_cu = 0;
        if (hipGetDevice(&dev) != hipSuccess || hipDeviceGetAttribute(&cus, hipDeviceAttributeMultiprocessorCount, dev) != hipSuccess) { grid = -1; return; }
        if (hipFuncSetAttribute((const void*)fwd_kernel, hipFuncAttributeMaxDynamicSharedMemorySize, LDS_BYTES) != hipSuccess) { fprintf(stderr, "kernel_launch: hipFuncSetAttribute failed\n"); grid = -1; return; }
        if (hipOccupancyMaxActiveBlocksPerMultiprocessor(&per_cu, (const void*)fwd_kernel, NWAVES * 64, LDS_BYTES) != hipSuccess || per_cu < 1) { fprintf(stderr, "kernel_launch: occupancy query says %d blocks per CU; nothing launched\n", per_cu); (void)hipGetLastError(); grid = -1; return; }
        grid = cus;
    }
    if (grid < 0) return;
    if (hipMemsetAsync((char*)d_ws + WS_CTL, 0, CTL_ZERO_BYTES, stream) != hipSuccess) { fprintf(stderr, "kernel_launch: memset failed\n"); return; }
    Args a{};
    for (int i = 0; i < 16; ++i) a.in[i] = d_in[i];
    a.out = (float*)d_out; a.ws = (unsigned char*)d_ws;
    hipLaunchKernelGGL(fwd_kernel, dim3(grid), dim3(NWAVES * 64), LDS_BYTES, stream, a);
}
```

```cpp
#include <cmath>
#include <hip/hip_runtime.h>
#include <cstdio>
#include <cstdint>
namespace pg8 {
#define PG8_LAS __attribute__((address_space(3)))
typedef unsigned short bf16_t;
typedef short bf16x8 __attribute__((ext_vector_type(8)));
typedef float f32x4 __attribute__((ext_vector_type(4)));
typedef unsigned u32x4 __attribute__((ext_vector_type(4)));
constexpr int BM = 256, BK = 64, HALF = 128, HTB = HALF * BK * 2  , STAGE_BYTES = 8 * HTB, NXCD = 8, WGM = 8;

__host__ __device__ __forceinline__ int lds_byte(int r, int c) { const int st = (r >> 4) * 2 + (c >> 5), rr = r & 15, cc = c & 31, ob = rr * 64 + cc * 2; return st * 1024 + (ob ^ (((ob >> 9) & 1) << 5)); }
__host__ __device__ __forceinline__ void stage_rc(int b, int& R, int& C) { const int st = b / 1024, sb = b % 1024, swz = sb ^ (((sb >> 9) & 1) << 5); R = (st >> 1) * 16 + swz / 64; C = (st & 1) * 32 + (swz % 64) / 2; }
__host__ __device__ __forceinline__ int perm32(int rho) { const int n = rho >> 4, i = rho & 15; return 8 * (i >> 2) + 4 * n + (i & 3); }

struct Unit { int pm, pn; };
struct Gemm { const bf16_t* A; const bf16_t* Bt; int M, N, K; };

struct StaticOrder {
    int nM, nN, nwg, G, c;
    __host__ __device__ void init(int M, int N, int G_, int c_) { nM = M / BM; nN = N / BM; nwg = nM * nN; G = G_; c = c_; }
    __host__ __device__ bool next(int i, Unit& u) const {
        const long L = (long)i * G + c; if (L >= nwg) return false;
        int wgid = (int)L; { const int q = nwg / NXCD, r = nwg % NXCD, xcd = wgid % NXCD, off = wgid / NXCD; wgid = (xcd < r ? xcd * (q + 1) : r * (q + 1) + (xcd - r) * q) + off; }
        const int nig = WGM * nN, gid = wgid / nig, fm = gid * WGM, gsz = (nM - fm) < WGM ? (nM - fm) : WGM;
        u.pm = fm + ((wgid % nig) % gsz); u.pn = (wgid % nig) / gsz; return true;
    }
    __device__ __forceinline__ void a_ready(const Unit&) const {}
    __device__ __forceinline__ void done(const Unit&) const {}
};

__device__ __forceinline__ unsigned cvt_pk_bf16(float lo, float hi) { unsigned r; asm volatile("v_cvt_pk_bf16_f32 %0, %1, %2" : "=v"(r) : "v"(lo), "v"(hi)); return r; }
typedef float f32x2 __attribute__((ext_vector_type(2)));
__device__ __forceinline__ f32x2 gelu_pk(f32x2 v) {
    const f32x2 av = __builtin_elementwise_abs(v), d = av * 0.2316418882f + 1.0f;
    f32x2 t; t.x = __builtin_amdgcn_rcpf(d.x); t.y = __builtin_amdgcn_rcpf(d.y);
    f32x2 q = t * 0.5307027145f + (-0.7265760135f); q = q * t + 0.7107068705f; q = q * t + (-0.142248368f); q = q * t + 0.127414796f; q = q * t;
    const f32x2 s = (v * v) * (-0.72134752044f);
    f32x2 e; e.x = __builtin_amdgcn_exp2f(s.x); e.y = __builtin_amdgcn_exp2f(s.y);
    const f32x2 m = v * (q * e), r = v - m;
    f32x2 o; o.x = v.x < 0.f ? m.x : r.x; o.y = v.y < 0.f ? m.y : r.y; return o;
}

template <int ACT  > struct EpiBf16 {
    static constexpr bool PERM = true, AFTER_DRAIN = false; static_assert(ACT == 0 || ACT == 1 || ACT == 2, "EpiBf16: ACT is 0 (none), 1 (gelu_pk) or 2 (squared relu)");
    bf16_t* O; int ldc; const float* bias; int split_cols; size_t split_stride; float scale0;
    __device__ __forceinline__ void operator()(const f32x4 (&acc)[2][2][4][2], const Unit& u, int wr, int wc, int fr, int fq) const {
        const int row0 = u.pm * BM + wr * 64 + fr; int colt = u.pn * BM; bf16_t* base = O;
        float sc = 1.f; if (split_cols) { const int t = colt / split_cols; base += (size_t)t * split_stride; colt -= t * split_cols; if (t == 0) sc = scale0; }
        const int col0 = colt + wc * 32 + 8 * fq, bcol0 = u.pn * BM + wc * 32 + 8 * fq;
        f32x4 bv[2][2];
#pragma unroll
        for (int bj = 0; bj < 2; ++bj)
#pragma unroll
            for (int n = 0; n < 2; ++n) bv[bj][n] = bias ? *(const f32x4*)(bias + bcol0 + bj * HALF + 4 * n) : (f32x4){0.f, 0.f, 0.f, 0.f};
#pragma unroll
        for (int ai = 0; ai < 2; ++ai)
#pragma unroll
            for (int m = 0; m < 4; ++m) { bf16_t* rowp = base + (size_t)(row0 + ai * HALF + m * 16) * ldc + col0;
#pragma unroll
                for (int bj = 0; bj < 2; ++bj) { f32x4 v0 = acc[ai][bj][m][0] + bv[bj][0], v1 = acc[ai][bj][m][1] + bv[bj][1];
                    if (ACT == 1) { f32x2 a = gelu_pk((f32x2){v0[0], v0[1]}), b = gelu_pk((f32x2){v0[2], v0[3]}), c = gelu_pk((f32x2){v1[0], v1[1]}), d = gelu_pk((f32x2){v1[2], v1[3]});
                        v0 = (f32x4){a.x, a.y, b.x, b.y}; v1 = (f32x4){c.x, c.y, d.x, d.y}; }
                    if (ACT == 2) { v0 = __builtin_elementwise_max(v0, (f32x4){0.f, 0.f, 0.f, 0.f}); v1 = __builtin_elementwise_max(v1, (f32x4){0.f, 0.f, 0.f, 0.f}); v0 = v0 * v0; v1 = v1 * v1; }
                    v0 = v0 * sc; v1 = v1 * sc; u32x4 w; w.x = cvt_pk_bf16(v0[0], v0[1]); w.y = cvt_pk_bf16(v0[2], v0[3]); w.z = cvt_pk_bf16(v1[0], v1[1]); w.w = cvt_pk_bf16(v1[2], v1[3]);
                    *(u32x4*)(rowp + bj * HALF) = w; } }
    }
};


struct EpiResGate {
    static constexpr bool PERM = false, AFTER_DRAIN = false;
    const float* base; float* out; int ldc; const float* gate; int gate_stride; int rows_per_batch;
    __device__ __forceinline__ void operator()(const f32x4 (&acc)[2][2][4][2], const Unit& u, int wr, int wc, int fr, int fq) const {
        const int row0 = u.pm * BM + wr * 64 + fr, col0 = u.pn * BM + wc * 32 + 4 * fq;
        const float* gp = gate + (size_t)((u.pm * BM) / rows_per_batch) * gate_stride + col0;
        f32x4 gv[2][2];
#pragma unroll
        for (int bj = 0; bj < 2; ++bj)
#pragma unroll
            for (int n = 0; n < 2; ++n) gv[bj][n] = *(const f32x4*)(gp + bj * HALF + n * 16);
#pragma unroll
        for (int ai = 0; ai < 2; ++ai)
#pragma unroll
            for (int m = 0; m < 4; ++m) { const size_t off = (size_t)(row0 + ai * HALF + m * 16) * ldc + col0;
#pragma unroll
                for (int bj = 0; bj < 2; ++bj)
#pragma unroll
                    for (int n = 0; n < 2; ++n) { const f32x4 bs = *(const f32x4*)(base + off + bj * HALF + n * 16); *(f32x4*)(out + off + bj * HALF + n * 16) = bs + gv[bj][n] * acc[ai][bj][m][n]; }
                if (m & 1) asm volatile("" ::: "memory"); }
    }
};

template <class Epi, class Sched, bool ALIGN_EPI = false, bool SP2 = false>
__device__ __forceinline__ void gemm_phase(PG8_LAS unsigned char* lds, const Gemm g, const Sched& S, const Epi& E) {
    int tid_ = threadIdx.x; asm volatile("" : "+v"(tid_));
    const int tid = tid_, wid = __builtin_amdgcn_readfirstlane(tid >> 6), lane = tid & 63, wr = wid >> 2, wc = wid & 3, fr = lane & 15, fq = lane >> 4;
    const int K = g.K, nt = K / BK;
    unsigned voffA[2], voffB[2];
#pragma unroll
    for (int i = 0; i < 2; ++i) { int R, C; stage_rc(tid * 16 + i * 8192, R, C); const int Rb = Epi::PERM ? ((R & ~31) + perm32(R & 31)) : R;
        voffA[i] = (unsigned)(R * K + C) * 2u; voffB[i] = (unsigned)(Rb * K + C) * 2u; }
    const size_t kstep = (size_t)(BK * 2);
    const size_t hstep = (size_t)HALF * K * 2;
    const size_t tstep = 2 * hstep;
    const unsigned ldsw = (unsigned)wid * 1024u;
    const int aoff = lds_byte(wr * 64 + fr, fq * 8), boff = lds_byte(wc * 32 + fr, fq * 8);
#define PG8_SA(b, h) (((b) * 2 + (h)) * HTB)
#define PG8_SB(b, h) ((4 + (b) * 2 + (h)) * HTB)
#define PG8_STAGE(bufoff, gbase, voff) do { _Pragma("unroll") for (int _i = 0; _i < 2; ++_i) \
        __builtin_amdgcn_global_load_lds((const unsigned*)((const char*)(gbase) + (voff)[_i]), (PG8_LAS unsigned*)(lds + (bufoff) + ldsw + _i * 8192), 16, 0, 0); } while (0)
#define PG8_LDA(dst, b, h) do { _Pragma("unroll") for (int m = 0; m < 4; ++m) _Pragma("unroll") for (int k = 0; k < 2; ++k) dst[m][k] = *(const PG8_LAS bf16x8*)(lds + PG8_SA(b, h) + aoff + m * 2048 + k * 1024); } while (0)
#define PG8_LDB(dst, b, h) do { _Pragma("unroll") for (int n = 0; n < 2; ++n) _Pragma("unroll") for (int k = 0; k < 2; ++k) dst[n][k] = *(const PG8_LAS bf16x8*)(lds + PG8_SB(b, h) + boff + n * 2048 + k * 1024); } while (0)
#define PG8_MMA(ai, bj, At, Bt) do { __builtin_amdgcn_s_setprio(1); _Pragma("unroll") for (int m = 0; m < 4; ++m) _Pragma("unroll") for (int n = 0; n < 2; ++n) _Pragma("unroll") for (int k = 0; k < 2; ++k) \
        acc[ai][bj][m][n] = __builtin_amdgcn_mfma_f32_16x16x32_bf16(Bt[n][k], At[m][k], acc[ai][bj][m][n], 0, 0, 0); __builtin_amdgcn_s_setprio(0); } while (0)
#define PG8_WAIT_V(n) asm volatile("s_waitcnt vmcnt(" #n ")" ::: "memory")
#define PG8_WAIT_L(n) asm volatile("s_waitcnt lgkmcnt(" #n ")" ::: "memory")
#define PG8_BAR __builtin_amdgcn_s_barrier()
#define PG8_SCHED __builtin_amdgcn_sched_barrier(0)
    Unit cur, nxt; int ui = 0;
    if (!S.next(0, cur)) return;
    f32x4 acc[2][2][4][2];
#pragma unroll
    for (int a = 0; a < 2; ++a)
#pragma unroll
        for (int b = 0; b < 2; ++b)
#pragma unroll
            for (int m = 0; m < 4; ++m)
#pragma unroll
                for (int n = 0; n < 2; ++n) acc[a][b][m][n] = (f32x4){0.f, 0.f, 0.f, 0.f};
    bf16x8 At[4][2], B0[2][2], B1[2][2];
    const char* cA = (const char*)g.A + (size_t)cur.pm * tstep; const char* cB = (const char*)g.Bt + (size_t)cur.pn * tstep;
    S.a_ready(cur);
    if constexpr (SP2) {
        PG8_STAGE(PG8_SB(0, 0), cB, voffB); PG8_STAGE(PG8_SB(0, 1), cB + hstep, voffB); PG8_STAGE(PG8_SA(0, 0), cA, voffA); PG8_STAGE(PG8_SA(0, 1), cA + hstep, voffA);
        if (wr == 1) PG8_BAR;
        PG8_WAIT_V(2); PG8_BAR;
        PG8_STAGE(PG8_SB(1, 0), cB + kstep, voffB); PG8_STAGE(PG8_SA(1, 0), cA + kstep, voffA); PG8_STAGE(PG8_SB(1, 1), cB + hstep + kstep, voffB);
        PG8_WAIT_V(6); PG8_BAR;
    } else {
        PG8_STAGE(PG8_SB(0, 0), cB, voffB); PG8_STAGE(PG8_SA(0, 0), cA, voffA); PG8_STAGE(PG8_SB(0, 1), cB + hstep, voffB); PG8_STAGE(PG8_SA(0, 1), cA + hstep, voffA);
        if (wr == 1) PG8_BAR;
        PG8_WAIT_V(4); PG8_BAR;
        PG8_STAGE(PG8_SB(1, 0), cB + kstep, voffB); PG8_STAGE(PG8_SA(1, 0), cA + kstep, voffA); PG8_STAGE(PG8_SB(1, 1), cB + hstep + kstep, voffB);
        PG8_WAIT_V(6); PG8_BAR;
    }
    for (;;) {
        const bool has_next = S.next(ui + 1, nxt);
        const char* nA = has_next ? (const char*)g.A + (size_t)nxt.pm * tstep : cA; const char* nB = has_next ? (const char*)g.Bt + (size_t)nxt.pn * tstep : cB;
        for (int t = 0; t < nt; t += 2) {
            const bool last = (t == nt - 2);
            const char* a1 = cA + (size_t)(t + 1) * kstep;
            const char* a2 = last ? nA : cA + (size_t)(t + 2) * kstep; const char* b2 = last ? nB : cB + (size_t)(t + 2) * kstep;
            const char* a3 = a2 + kstep; const char* b3 = b2 + kstep;
            if (last && has_next) S.a_ready(nxt);
            if constexpr (SP2) {
            PG8_LDB(B0, 0, 0); PG8_LDB(B1, 0, 1); PG8_SCHED; PG8_LDA(At, 0, 0); PG8_STAGE(PG8_SA(1, 1), a1 + hstep, voffA);
            PG8_WAIT_V(8); PG8_WAIT_L(0); PG8_BAR; PG8_MMA(0, 0, At, B0); PG8_MMA(0, 1, At, B1); PG8_BAR; PG8_SCHED;
            PG8_LDA(At, 0, 1); PG8_STAGE(PG8_SB(0, 0), b2, voffB); PG8_STAGE(PG8_SB(0, 1), b2 + hstep, voffB); PG8_STAGE(PG8_SA(0, 0), a2, voffA);
            PG8_WAIT_V(8); PG8_WAIT_L(0); PG8_BAR; PG8_MMA(1, 0, At, B0); PG8_MMA(1, 1, At, B1); PG8_BAR; PG8_SCHED;
            PG8_LDB(B0, 1, 0); PG8_LDB(B1, 1, 1); PG8_SCHED; PG8_LDA(At, 1, 0); PG8_STAGE(PG8_SA(0, 1), a2 + hstep, voffA);
            PG8_WAIT_V(8); PG8_WAIT_L(0); PG8_BAR; PG8_MMA(0, 0, At, B0); PG8_MMA(0, 1, At, B1); PG8_BAR; PG8_SCHED;
            PG8_LDA(At, 1, 1); PG8_STAGE(PG8_SB(1, 0), b3, voffB); PG8_STAGE(PG8_SB(1, 1), b3 + hstep, voffB); PG8_STAGE(PG8_SA(1, 0), a3, voffA);
            PG8_WAIT_V(8); PG8_WAIT_L(0); PG8_BAR; PG8_MMA(1, 0, At, B0); PG8_MMA(1, 1, At, B1); PG8_BAR; PG8_SCHED;
            } else {
            PG8_LDB(B0, 0, 0); PG8_SCHED; PG8_LDA(At, 0, 0); PG8_STAGE(PG8_SA(1, 1), a1 + hstep, voffA);
            PG8_WAIT_L(8); PG8_BAR; PG8_WAIT_L(0); PG8_MMA(0, 0, At, B0); PG8_BAR; PG8_SCHED;
            PG8_LDB(B1, 0, 1); PG8_STAGE(PG8_SB(0, 0), b2, voffB);
            PG8_BAR; PG8_WAIT_L(0); PG8_MMA(0, 1, At, B1); PG8_BAR;
            PG8_LDA(At, 0, 1); PG8_STAGE(PG8_SA(0, 0), a2, voffA);
            PG8_BAR; PG8_WAIT_L(0); PG8_MMA(1, 0, At, B0); PG8_BAR; PG8_SCHED;
            PG8_STAGE(PG8_SB(0, 1), b2 + hstep, voffB);
            PG8_WAIT_V(6); PG8_BAR; PG8_MMA(1, 1, At, B1); PG8_BAR;
            PG8_LDB(B0, 1, 0); PG8_SCHED; PG8_LDA(At, 1, 0); PG8_STAGE(PG8_SA(0, 1), a2 + hstep, voffA);
            PG8_WAIT_L(8); PG8_BAR; PG8_WAIT_L(0); PG8_MMA(0, 0, At, B0); PG8_BAR; PG8_SCHED;
            PG8_LDB(B1, 1, 1); PG8_STAGE(PG8_SB(1, 0), b3, voffB);
            PG8_BAR; PG8_WAIT_L(0); PG8_MMA(0, 1, At, B1); PG8_BAR;
            PG8_LDA(At, 1, 1); PG8_STAGE(PG8_SA(1, 0), a3, voffA);
            PG8_BAR; PG8_WAIT_L(0); PG8_MMA(1, 0, At, B0); PG8_BAR; PG8_SCHED;
            PG8_STAGE(PG8_SB(1, 1), b3 + hstep, voffB);
            PG8_WAIT_V(6); PG8_BAR; PG8_MMA(1, 1, At, B1); PG8_BAR;
            }
        }
        if constexpr (ALIGN_EPI) { if (wr == 0) PG8_BAR; }
        if constexpr (!Epi::AFTER_DRAIN) { E(acc, cur, wr, wc, fr, fq); S.done(cur); }
        if (!has_next) break;
#pragma unroll
        for (int a = 0; a < 2; ++a)
#pragma unroll
            for (int b = 0; b < 2; ++b)
#pragma unroll
                for (int m = 0; m < 4; ++m)
#pragma unroll
                    for (int n = 0; n < 2; ++n) acc[a][b][m][n] = (f32x4){0.f, 0.f, 0.f, 0.f};
        cur = nxt; cA = nA; cB = nB; ++ui;
        if constexpr (ALIGN_EPI) { if (wr == 1) PG8_BAR; }
    }
    PG8_WAIT_V(0);
    if constexpr (!ALIGN_EPI) { if (wr == 0) PG8_BAR; }
    PG8_BAR;
    if constexpr (Epi::AFTER_DRAIN) { E.fused(acc, cur, wr, wc, fr, fq, lds, wid, lane); S.done(cur); }
#undef PG8_SA
#undef PG8_SB
#undef PG8_STAGE
#undef PG8_LDA
#undef PG8_LDB
#undef PG8_MMA
#undef PG8_WAIT_V
#undef PG8_WAIT_L
#undef PG8_BAR
#undef PG8_SCHED
}
}

#ifndef PG8_SP2
#define PG8_SP2 true
#endif
#ifndef PG8_ALIGN
#define PG8_ALIGN true
#endif
#define GAS __attribute__((address_space(1)))
#define LAS __attribute__((address_space(3)))
typedef unsigned short bf16;
typedef unsigned v4u __attribute__((ext_vector_type(4)));
typedef float f32x4 __attribute__((ext_vector_type(4)));
typedef short bf16x8 __attribute__((ext_vector_type(8)));
typedef GAS unsigned gu32;
typedef GAS unsigned long long gu64;
#define RLX_AGENT __ATOMIC_RELAXED, __HIP_MEMORY_SCOPE_AGENT
#define LDS_WAIT() asm volatile("s_waitcnt lgkmcnt(0)" ::: "memory")
#define VM_WAIT() asm volatile("s_waitcnt vmcnt(0)" ::: "memory")
__device__ __forceinline__ unsigned long long rt() { return __builtin_amdgcn_s_memrealtime(); }
__device__ __forceinline__ unsigned f2bf(float f) { unsigned u = __builtin_bit_cast(unsigned, f); return (u + 0x7fffu + ((u >> 16) & 1u)) >> 16; }
__device__ __forceinline__ unsigned pk2(float lo, float hi) { return f2bf(lo) | (f2bf(hi) << 16); }

#define XB_TMO      128
#define XB_XCNT(j)  (256  + 64 * (j))
#define XB_XSUB(j)  (1280 + 64 * (j))
#define XB_XGEN(j)  (2304 + 64 * (j))
#define XB_TOP      3328
#define XB_TOPGEN   3392
#define XCD_BAR_WORDS 3456
#define XB_SPIN_CAP (1u << 22)

__device__ __forceinline__ unsigned xb_ld(unsigned* p)              { return __hip_atomic_load(p, __ATOMIC_RELAXED, __HIP_MEMORY_SCOPE_AGENT); }
__device__ __forceinline__ unsigned xb_add(unsigned* p, unsigned v) { return __hip_atomic_fetch_add(p, v, __ATOMIC_RELAXED, __HIP_MEMORY_SCOPE_AGENT); }
__device__ __forceinline__ unsigned xb_xcc_id() { return (unsigned)__builtin_amdgcn_s_getreg((3 << 11) | 20) & 0xFu; }
#define XB_SPIN(cond, bar) do { unsigned _sp = 0; while (cond) { __builtin_amdgcn_s_sleep(1); \
    if ((++_sp & 255u) == 0u) { if (xb_ld(&(bar)[XB_TMO])) break; if (_sp > XB_SPIN_CAP) { atomicAdd(&(bar)[XB_TMO], 1u); break; } } } } while (0)

struct XcdBarrier {
    unsigned* bar; unsigned x;
    volatile LAS unsigned* st;
};

__device__ __forceinline__ XcdBarrier xcd_barrier_post(unsigned* bar, volatile LAS unsigned* st) {
    XcdBarrier b; b.bar = bar; b.x = xb_xcc_id(); b.st = st;
    if (threadIdx.x == 0) (void)xb_add(&bar[XB_XCNT(b.x)], 1u);
    return b;
}
__device__ __forceinline__ void xcd_barrier_complete(unsigned* bar, unsigned x, unsigned& nloc, unsigned& nx) {
    const unsigned G = gridDim.x * gridDim.y * gridDim.z;
    unsigned sum, cnt, mine, sp = 0u;
    for (;;) {
        sum = 0u; cnt = 0u; mine = 0u;
#pragma unroll
        for (unsigned j = 0; j < 16; ++j) { const unsigned c = xb_ld(&bar[XB_XCNT(j)]); sum += c; cnt += (c > 0u) ? 1u : 0u; mine = (j == x) ? c : mine; }
        if (sum == G) break;
        __builtin_amdgcn_s_sleep(1);
        if ((++sp & 255u) == 0u) { if (xb_ld(&bar[XB_TMO])) break; if (sp > XB_SPIN_CAP) { atomicAdd(&bar[XB_TMO], 1u); break; } }
    }
    nloc = mine > 0u ? mine : 1u; nx = cnt > 0u ? cnt : 1u;
}

__device__ __forceinline__ void xcd_barrier(const XcdBarrier& b) {
    asm volatile("s_waitcnt vmcnt(0)" ::: "memory");
    __syncthreads();
    if (threadIdx.x == 0) {
        unsigned* bar = b.bar;
        __builtin_amdgcn_s_waitcnt(0);
        unsigned nloc = b.st[0], nx = b.st[1];
        if (nloc == 0u) { xcd_barrier_complete(bar, b.x, nloc, nx); b.st[0] = nloc; b.st[1] = nx; }
        const unsigned old = xb_add(&bar[XB_XSUB(b.x)], 1u);
        const unsigned gen = old / nloc;
        if (old + 1u == (gen + 1u) * nloc) {
            __builtin_amdgcn_fence(__ATOMIC_RELEASE, "agent");
            asm volatile("s_waitcnt vmcnt(0)" ::: "memory");
            const unsigned og = xb_add(&bar[XB_TOP], 1u);
            const unsigned tg = og / nx;
            if (og + 1u == (tg + 1u) * nx) xb_add(&bar[XB_TOPGEN], 1u);
            else XB_SPIN(xb_ld(&bar[XB_TOPGEN]) == tg, bar);
            __builtin_amdgcn_fence(__ATOMIC_ACQUIRE, "agent");
            xb_add(&bar[XB_XGEN(b.x)], 1u);
            asm volatile("s_waitcnt vmcnt(0)" ::: "memory");
        } else {
            XB_SPIN(xb_ld(&bar[XB_XGEN(b.x)]) == gen, bar);
            __builtin_amdgcn_fence(__ATOMIC_ACQUIRE, "agent");
            asm volatile("s_waitcnt vmcnt(0)" ::: "memory");
        }
    }
    __syncthreads();
}


constexpr int NWAVES = 8;
constexpr int NB = 4, S = 8192, D = 1024, M = NB * S, FF = 4096;
constexpr int DIN = 2376, DINP = 2560;
constexpr int C_Q = 0, C_K = 512, C_V = 640, C_QI = 768, C_KI = 1280, C_WI = 1344, C_A = 1352, C_G = 1864;
constexpr int CONVK = 31, CCH = 512, MODW = 6 * D;
constexpr float EPS = 1e-6f;
constexpr float WI_SCALE = 0.04419417382415922f;
constexpr float SM_SCALE_LOG2E = 0.125f * 1.4426950408889634f;

constexpr size_t MiB = 1u << 20;
constexpr size_t WS_CTL = 0, CTL_ZERO_BYTES = 1 * MiB;
constexpr size_t WS_WIN = 1 * MiB, WS_WOUT = 6 * MiB, WS_WUP = 8 * MiB, WS_WDN = 16 * MiB;
constexpr size_t WS_MOD = 24 * MiB, WS_CS = 25 * MiB;
constexpr size_t WS_H = 32 * MiB;
constexpr size_t WS_PROJ = 96 * MiB;
constexpr size_t WS_Q = 256 * MiB, WS_K = 288 * MiB, WS_V = 296 * MiB, WS_QI = 304 * MiB, WS_KI = 336 * MiB, WS_WI = 340 * MiB, WS_GLU = 344 * MiB;
constexpr size_t WS_MIX = 376 * MiB;
constexpr size_t WS_U = 96 * MiB;
constexpr size_t WS_END = 440 * MiB;
constexpr int CW_BAR = 4096;

constexpr int RING_OFF = 0, RING_BYTES = 131072;
constexpr int LDSCTL_OFF = 147456, MISC_OFF = LDSCTL_OFF + 320;
constexpr int LDS_BYTES = 148480;

struct Frame {
    LAS unsigned char* lds;
    volatile LAS unsigned* MISC;
    gu32* ctl;
    int tid, lane, wave;
    int vcu, G;
    const float *x, *c, *w_ada, *b_ada, *g_mix, *w_in, *conv_w, *conv_b, *conv_ng, *conv_nb, *w_out, *g_mlp, *w_up, *w_down, *g_final;
    const int* positions;
    float* out;
    bf16 *Win_t, *Wout_t, *Wup_t, *Wdn_t;
    float *mod, *CS, *WI;
    bf16 *H, *PROJ, *Q, *K, *V, *QI, *KI, *GLU, *MIX, *U;
};

__device__ __forceinline__ float wave_sum(float v) {
#pragma unroll
    for (int o = 1; o < 64; o <<= 1) v += __shfl_xor(v, o);
    return v;
}
__device__ __forceinline__ float bf2f(unsigned u16) { return __uint_as_float(u16 << 16); }

__device__ __forceinline__ void p0_transpose_item(const float* W, int K, int N, int Npad, bf16* WT, LAS float* scr, int item, int lane) {
    const int nblk = Npad / 32, kb = item / nblk, nb = item % nblk, k0 = 64 * kb, n0 = 32 * nb;
    const int ncol = n0 + (lane & 31); const bool ok = ncol < N;
#pragma unroll 8
    for (int i = 0; i < 32; ++i) { const int kk = 2 * i + (lane >> 5); scr[kk * 33 + (lane & 31)] = ok ? W[(size_t)(k0 + kk) * N + ncol] : 0.f; }
    LDS_WAIT(); asm volatile("" ::: "memory");
    const int c = lane & 7;
#pragma unroll
    for (int j = 0; j < 4; ++j) { const int n = (lane >> 3) + 8 * j; const LAS float* s = scr + (8 * c) * 33 + n;
        v4u o; o.x = pk2(s[0 * 33], s[1 * 33]); o.y = pk2(s[2 * 33], s[3 * 33]); o.z = pk2(s[4 * 33], s[5 * 33]); o.w = pk2(s[6 * 33], s[7 * 33]);
        *(GAS v4u*)(WT + (size_t)(n0 + n) * K + k0 + 8 * c) = o; }
    LDS_WAIT(); asm volatile("" ::: "memory");
}

__device__ __forceinline__ void p0_prologue(Frame& F) {
    LAS float* cond = (LAS float*)(F.lds + 73728);
    for (int i = F.tid; i < NB * D; i += NWAVES * 64) { const float v = F.c[i]; cond[i] = v / (1.f + expf(-v)); }
    __syncthreads();
    const int gw = F.vcu * NWAVES + F.wave, NGW = F.G * NWAVES, lane = F.lane;
    for (int it = gw; it < MODW / 16; it += NGW) {
        const int col = it * 16 + (lane & 15), kg = lane >> 4;
        float a0 = 0.f, a1 = 0.f, a2 = 0.f, a3 = 0.f;
        const float* wp = F.w_ada + (size_t)kg * MODW + col;
#pragma unroll 16
        for (int i = 0; i < D / 4; ++i) { const int k = kg + 4 * i; const float w = wp[(size_t)i * 4 * MODW];
            a0 += w * cond[k]; a1 += w * cond[D + k]; a2 += w * cond[2 * D + k]; a3 += w * cond[3 * D + k]; }
        a0 += __shfl_xor(a0, 16); a0 += __shfl_xor(a0, 32); a1 += __shfl_xor(a1, 16); a1 += __shfl_xor(a1, 32);
        a2 += __shfl_xor(a2, 16); a2 += __shfl_xor(a2, 32); a3 += __shfl_xor(a3, 16); a3 += __shfl_xor(a3, 32);
        if (lane < 16) { const float bb = F.b_ada[col]; F.mod[col] = a0 + bb; F.mod[MODW + col] = a1 + bb; F.mod[2 * MODW + col] = a2 + bb; F.mod[3 * MODW + col] = a3 + bb; }
    }
    LAS float* scr = (LAS float*)(F.lds + F.wave * 8448);
    constexpr int I_IN = (D / 64) * (DINP / 32), I_OUT = (D / 64) * (D / 32), I_UP = (D / 64) * (FF / 32), I_DN = (FF / 64) * (D / 32);
    constexpr int NITEMS = I_IN + I_OUT + I_UP + I_DN;
    for (int it = gw; it < NITEMS; it += NGW) {
        int r = it;
        if (r < I_IN) { p0_transpose_item(F.w_in, D, DIN, DINP, F.Win_t, scr, r, lane); continue; } r -= I_IN;
        if (r < I_OUT) { p0_transpose_item(F.w_out, D, D, D, F.Wout_t, scr, r, lane); continue; } r -= I_OUT;
        if (r < I_UP) { p0_transpose_item(F.w_up, D, FF, FF, F.Wup_t, scr, r, lane); continue; } r -= I_UP;
        p0_transpose_item(F.w_down, FF, D, D, F.Wdn_t, scr, r, lane);
    }
    for (int i = gw * 64 + lane; i < M * 8; i += NGW * 64) {
        const int m = i >> 3, f = i & 7;
        const float invf = (f == 0) ? 1.0f : (f == 1) ? 0.1939227432012558f : (f == 2) ? 0.03760603070259094f : (f == 3) ? 0.007292664609849453f
                         : (f == 4) ? 0.0014142135623842478f : (f == 5) ? 0.00027424818836152554f : (f == 6) ? 5.3182957344688475e-05f : 1.0313385246263351e-05f;
        const float ang = (float)F.positions[m] * invf;
        const double a = (double)ang, q = rint(a * 0.63661977236758134308), rr = a - q * 1.57079632679489661923, r2 = rr * rr;
        const int n = (int)q;
        const double sn = rr * (1.0 + r2 * (-1.0 / 6 + r2 * (1.0 / 120 + r2 * (-1.0 / 5040 + r2 * (1.0 / 362880 + r2 * (-1.0 / 39916800 + r2 * (1.0 / 6227020800.0)))))));
        const double cs = 1.0 + r2 * (-0.5 + r2 * (1.0 / 24 + r2 * (-1.0 / 720 + r2 * (1.0 / 40320 + r2 * (-1.0 / 3628800 + r2 * (1.0 / 479001600 + r2 * (-1.0 / 87178291200.0)))))));
        double so, co;
        switch (n & 3) { case 0: so = sn; co = cs; break; case 1: so = cs; co = -sn; break; case 2: so = -sn; co = -cs; break; default: so = -cs; co = sn; break; }
        F.CS[(size_t)m * 16 + f] = (float)co; F.CS[(size_t)m * 16 + 8 + f] = (float)so;
    }
}

__device__ __forceinline__ void normmod_rows(Frame& F, const float* X, const float* g, const float* sh, const float* sc, bf16* out) {
    const int gw = F.vcu * NWAVES + F.wave, NGW = F.G * NWAVES, lane = F.lane;
    for (int blk = gw; blk < M / 16; blk += NGW) {
        const int r0 = blk * 16, b = r0 / S;
        f32x4 A[4], Bv[4];
#pragma unroll
        for (int j = 0; j < 4; ++j) { const int c = 4 * lane + 256 * j; const f32x4 gg = *(const f32x4*)(g + c), s1 = *(const f32x4*)(sc + (size_t)b * MODW + c);
            A[j] = gg * (s1 + 1.0f); Bv[j] = *(const f32x4*)(sh + (size_t)b * MODW + c); }
        for (int r = 0; r < 16; ++r) {
            const GAS f32x4* xr = (const GAS f32x4*)(X + (size_t)(r0 + r) * D) + lane;
            f32x4 v[4]; float ss = 0.f;
#pragma unroll
            for (int j = 0; j < 4; ++j) { v[j] = xr[64 * j]; ss += (v[j].x * v[j].x + v[j].y * v[j].y) + (v[j].z * v[j].z + v[j].w * v[j].w); }
            const float rinv = 1.0f / sqrtf(wave_sum(ss) * (1.0f / D) + EPS);
            GAS unsigned long long* o8 = (GAS unsigned long long*)(out + (size_t)(r0 + r) * D) + lane;
#pragma unroll
            for (int j = 0; j < 4; ++j) { const f32x4 y = v[j] * rinv * A[j] + Bv[j];
                o8[64 * j] = (unsigned long long)pk2(y.x, y.y) | ((unsigned long long)pk2(y.z, y.w) << 32); }
        }
    }
}
__device__ __forceinline__ void final_norm_rows(Frame& F, float* X, const float* g) {
    const int gw = F.vcu * NWAVES + F.wave, NGW = F.G * NWAVES, lane = F.lane;
    f32x4 A[4];
#pragma unroll
    for (int j = 0; j < 4; ++j) A[j] = *(const f32x4*)(g + 4 * lane + 256 * j);
    for (int blk = gw; blk < M / 16; blk += NGW) {
        for (int r = 0; r < 16; ++r) {
            GAS f32x4* xr = (GAS f32x4*)(X + (size_t)(blk * 16 + r) * D) + lane;
            f32x4 v[4]; float ss = 0.f;
#pragma unroll
            for (int j = 0; j < 4; ++j) { v[j] = xr[64 * j]; ss += (v[j].x * v[j].x + v[j].y * v[j].y) + (v[j].z * v[j].z + v[j].w * v[j].w); }
            const float rinv = 1.0f / sqrtf(wave_sum(ss) * (1.0f / D) + EPS);
#pragma unroll
            for (int j = 0; j < 4; ++j) xr[64 * j] = v[j] * rinv * A[j];
        }
    }
}

__device__ __forceinline__ void p3_post(Frame& F) {
    const int gw = F.vcu * NWAVES + F.wave, NGW = F.G * NWAVES, lane = F.lane;
    const int l31 = lane & 31; const bool rot = l31 < 8, isx1 = l31 < 4; const int i0 = 2 * (lane & 3);
    for (int blk = gw; blk < M / 16; blk += NGW) {
        for (int r = 0; r < 16; ++r) {
            const size_t m = (size_t)blk * 16 + r;
            const bf16* pr = F.PROJ + m * DINP;
            const float c0 = F.CS[m * 16 + i0], c1 = F.CS[m * 16 + i0 + 1], s0 = F.CS[m * 16 + 8 + i0], s1 = F.CS[m * 16 + 8 + i0 + 1];
#pragma unroll
            for (int j = 0; j < 11; ++j) {
                const unsigned u = *(const unsigned*)(pr + 128 * j + 2 * lane);
                float v0 = bf2f(u & 0xffffu), v1 = bf2f(u >> 16);
                if (j != 5) {
                    const float p0 = __shfl_xor(v0, 4), p1 = __shfl_xor(v1, 4);
                    if (rot && !(j == 10 && lane >= 32)) {
                        if (isx1) { v0 = v0 * c0 - p0 * s0; v1 = v1 * c1 - p1 * s1; } else { v0 = v0 * c0 + p0 * s0; v1 = v1 * c1 + p1 * s1; }
                    }
                }
                const unsigned w = pk2(v0, v1);
                if (j < 4) *(unsigned*)(F.Q + m * 512 + 128 * j + 2 * lane) = w;
                else if (j == 4) *(unsigned*)(F.K + m * 128 + 2 * lane) = w;
                else if (j == 5) *(unsigned*)(F.V + m * 128 + 2 * lane) = w;
                else if (j < 10) *(unsigned*)(F.QI + m * 512 + 128 * (j - 6) + 2 * lane) = w;
                else { if (lane < 32) *(unsigned*)(F.KI + m * 64 + 2 * lane) = w;
                       else if (lane < 36) { F.WI[m * 8 + 2 * (lane - 32)] = v0 * WI_SCALE; F.WI[m * 8 + 2 * (lane - 32) + 1] = v1 * WI_SCALE; } }
            }
#pragma unroll
            for (int j = 0; j < 4; ++j) {
                const int ch = 128 * j + 2 * lane;
                const unsigned ua = *(const unsigned*)(pr + C_A + ch), ug = *(const unsigned*)(pr + C_G + ch);
                const float a0 = bf2f(ua & 0xffffu), a1 = bf2f(ua >> 16), g0 = bf2f(ug & 0xffffu), g1 = bf2f(ug >> 16);
                *(unsigned*)(F.GLU + m * CCH + ch) = pk2(a0 / (1.f + __expf(-g0)), a1 / (1.f + __expf(-g1)));
            }
        }
    }
}

__device__ __forceinline__ void p4_conv(Frame& F) {
    LAS f32x4* wl = (LAS f32x4*)(F.lds);
    LAS unsigned char* inl = F.lds + 63488;
    const int lane = F.lane;
    for (int i = F.tid; i < CONVK * CCH; i += NWAVES * 64) { const int j = i / CCH, ch = i % CCH;
        ((LAS float*)wl)[((j * 2 + ((ch >> 2) & 1)) * 64 + (ch >> 3)) * 4 + (ch & 3)] = F.conv_w[i]; }
    f32x4 cb[2], ng[2], nb[2];
#pragma unroll
    for (int h = 0; h < 2; ++h) { cb[h] = *(const f32x4*)(F.conv_b + 8 * lane + 4 * h); ng[h] = *(const f32x4*)(F.conv_ng + 8 * lane + 4 * h); nb[h] = *(const f32x4*)(F.conv_nb + 8 * lane + 4 * h); }
    for (int tile = F.vcu; tile < M / 32; tile += F.G) {
        __syncthreads();
        const int m0 = tile * 32, s0 = m0 & (S - 1);
        for (int i = F.tid; i < 62 * 64; i += NWAVES * 64) { const int r = i >> 6, cc = i & 63;
            v4u v = (v4u){0u, 0u, 0u, 0u};
            if (s0 - 30 + r >= 0) v = *(const v4u*)(F.GLU + (size_t)(m0 - 30 + r) * CCH + cc * 8);
            *(LAS v4u*)(inl + r * 1024 + cc * 16) = v; }
        __syncthreads();
        for (int tt = 0; tt < 4; ++tt) {
            const int tl = F.wave * 4 + tt;
            f32x4 a0 = cb[0], a1 = cb[1];
#pragma unroll 2
            for (int j = 0; j < CONVK; ++j) {
                const v4u in = *(const LAS v4u*)(inl + (tl + j) * 1024 + lane * 16);
                const f32x4 w0 = wl[(j * 2 + 0) * 64 + lane], w1 = wl[(j * 2 + 1) * 64 + lane];
                const f32x4 x0 = (f32x4){bf2f(in.x & 0xffffu), bf2f(in.x >> 16), bf2f(in.y & 0xffffu), bf2f(in.y >> 16)};
                const f32x4 x1 = (f32x4){bf2f(in.z & 0xffffu), bf2f(in.z >> 16), bf2f(in.w & 0xffffu), bf2f(in.w >> 16)};
                a0 += w0 * x0; a1 += w1 * x1;
            }
            const float mean = wave_sum((a0.x + a0.y) + (a0.z + a0.w) + (a1.x + a1.y) + (a1.z + a1.w)) * (1.0f / CCH);
            a0 = a0 - mean; a1 = a1 - mean;
            const float var = wave_sum((a0.x * a0.x + a0.y * a0.y) + (a0.z * a0.z + a0.w * a0.w) + (a1.x * a1.x + a1.y * a1.y) + (a1.z * a1.z + a1.w * a1.w)) * (1.0f / CCH);
            const float rstd = 1.0f / sqrtf(var + EPS);
            f32x4 y0 = a0 * rstd * ng[0] + nb[0], y1 = a1 * rstd * ng[1] + nb[1];
            y0 = (f32x4){y0.x / (1.f + __expf(-y0.x)), y0.y / (1.f + __expf(-y0.y)), y0.z / (1.f + __expf(-y0.z)), y0.w / (1.f + __expf(-y0.w))};
            y1 = (f32x4){y1.x / (1.f + __expf(-y1.x)), y1.y / (1.f + __expf(-y1.y)), y1.z / (1.f + __expf(-y1.z)), y1.w / (1.f + __expf(-y1.w))};
            v4u o; o.x = pk2(y0.x, y0.y); o.y = pk2(y0.z, y0.w); o.z = pk2(y1.x, y1.y); o.w = pk2(y1.z, y1.w);
            *(GAS v4u*)(F.MIX + (size_t)(m0 + tl) * D + CCH + 8 * lane) = o;
        }
    }
    __syncthreads();
}

constexpr int DC = 960, DNR = DC / 64, TOPK = 256, DSLACK = 64;
constexpr int DSA_RING = 0, DSA_SLOT = 8192, DSA_CAND = 3 * DSA_SLOT;
static_assert(DSA_CAND + 32 * DC * 4 <= LDSCTL_OFF, "DSA LDS map");
typedef float f32x16 __attribute__((ext_vector_type(16)));
typedef float f32x2 __attribute__((ext_vector_type(2)));
__device__ __forceinline__ unsigned ordkey(float s, int key) {
    unsigned u = __float_as_uint(s); u ^= (unsigned)((int)u >> 31) | 0x80000000u;
    return (u & 0xFFFFE000u) | (unsigned)(8191 - key);
}
__device__ __forceinline__ int mbcnt64(unsigned long long mk) { return (int)__builtin_amdgcn_mbcnt_hi((unsigned)(mk >> 32), __builtin_amdgcn_mbcnt_lo((unsigned)mk, 0u)); }
template <int SLACK>
__device__ __forceinline__ int dsa_compact(LAS unsigned* buf, int cnt, int lane, unsigned& tau) {
    unsigned e[DNR]; unsigned mxl = 0u;
#pragma unroll
    for (int i = 0; i < DNR; ++i) { const unsigned v = buf[i * 64 + lane]; e[i] = (i * 64 + lane < cnt) ? v : 0u; mxl = mxl > e[i] ? mxl : e[i]; }
#pragma unroll
    for (int o = 1; o < 64; o <<= 1) { const unsigned other = (unsigned)__shfl_xor((int)mxl, o); mxl = mxl > other ? mxl : other; }
    unsigned lo = tau, hi = (unsigned)__builtin_amdgcn_readfirstlane((int)mxl) + 1u, thr; int c;
#pragma unroll 1
    for (;;) {
        const unsigned mid = lo + ((hi - lo) >> 1); c = 0;
#pragma unroll
        for (int i = 0; i < DNR; ++i) c += __popcll(__ballot(e[i] >= mid));
        if (c < TOPK) hi = mid; else if (c > TOPK + SLACK) lo = mid; else { thr = mid; break; }
    }
    int base = 0;
#pragma unroll
    for (int i = 0; i < DNR; ++i) { const bool k = e[i] >= thr; const unsigned long long mk = __ballot(k); const int pos = base + mbcnt64(mk); if (k) buf[pos] = e[i]; base += __popcll(mk); }
    tau = thr; return base;
}

__device__ __forceinline__ void dsa_unit(Frame& F, int lane, int wave, int b, int qb) {
    const int r = lane & 31, hi = lane >> 5;
    const size_t mb = (size_t)b * S;
    const int t0 = 32 * qb + 4 * wave;
    LAS unsigned* cw = (LAS unsigned*)(F.lds + DSA_CAND) + wave * 4 * DC;
    const int a_ = r >> 2, i_ = r & 3, ql = ((a_ >> 2) & 1) + 2 * (a_ & 1), hd = 4 * ((a_ >> 1) & 1) + i_;
    const bf16* qip = F.QI + (mb + t0 + ql) * 512 + hd * 64 + hi * 8;
    bf16x8 A[4];
#pragma unroll
    for (int ks = 0; ks < 4; ++ks) A[ks] = *(const bf16x8*)(qip + ks * 16);
    f32x2 wv[8];
    { const f32x2* wp = (const f32x2*)(F.WI + (mb + t0 + 2 * hi) * 8);
#pragma unroll
      for (int q2 = 0; q2 < 8; ++q2) wv[q2] = wp[q2]; }
    const int tA = t0 + 2 * hi, tB = tA + 1;
    int cnt0 = 0, cnt1 = 0, cnt2 = 0, cnt3 = 0; unsigned tau0 = 0u, tau1 = 0u, tau2 = 0u, tau3 = 0u;
    const int nst = (qb >> 1) + 1;
    const int drow = 8 * wave + (lane >> 3), dch = (lane & 7) ^ ((drow >> 1) & 7);
    const bf16* dsrc = F.KI + (mb + drow) * 64 + dch * 8;
    LAS unsigned char* ring = F.lds + DSA_RING;
    int boff[4];
#pragma unroll
    for (int ks = 0; ks < 4; ++ks) boff[ks] = r * 128 + (((2 * ks + hi) ^ ((r >> 1) & 7)) << 4);
    volatile LAS unsigned* vote = F.MISC + 16;
#define DSA_DMA(stage, slot) __builtin_amdgcn_global_load_lds((const unsigned*)(dsrc + (size_t)(stage) * 64 * 64), (LAS unsigned*)(ring + (slot) * DSA_SLOT + wave * 1024), 16, 0, 0)
#define DSA_APPEND(pred, pk, cntL, cntH, qL, qH) do { const unsigned long long mk_ = __ballot(pred); const unsigned lo_ = (unsigned)mk_, hh_ = (unsigned)(mk_ >> 32); \
        const int pos_ = hi ? (cntH + (int)__builtin_amdgcn_mbcnt_hi(hh_, 0u)) : (cntL + (int)__builtin_amdgcn_mbcnt_lo(lo_, 0u)); \
        if (pred) cw[(hi ? (qH) : (qL)) * DC + pos_] = (pk); cntL += __popc(lo_); cntH += __popc(hh_); } while (0)
#define DSA_SUBTILE(sbase, s0_) do { \
        const bf16x8 B0 = *(const LAS bf16x8*)((sbase) + boff[0]), B1 = *(const LAS bf16x8*)((sbase) + boff[1]), B2 = *(const LAS bf16x8*)((sbase) + boff[2]), B3 = *(const LAS bf16x8*)((sbase) + boff[3]); \
        f32x16 acc = {0.f, 0.f, 0.f, 0.f, 0.f, 0.f, 0.f, 0.f, 0.f, 0.f, 0.f, 0.f, 0.f, 0.f, 0.f, 0.f}; \
        acc = __builtin_amdgcn_mfma_f32_32x32x16_bf16(A[0], B0, acc, 0, 0, 0); acc = __builtin_amdgcn_mfma_f32_32x32x16_bf16(A[1], B1, acc, 0, 0, 0); \
        acc = __builtin_amdgcn_mfma_f32_32x32x16_bf16(A[2], B2, acc, 0, 0, 0); acc = __builtin_amdgcn_mfma_f32_32x32x16_bf16(A[3], B3, acc, 0, 0, 0); \
        f32x2 sa = {0.f, 0.f}, sb = {0.f, 0.f}; \
        _Pragma("unroll") for (int g = 0; g < 4; ++g) { sa += wv[g] * (f32x2){fmaxf(acc[2 * g], 0.f), fmaxf(acc[2 * g + 1], 0.f)}; sb += wv[4 + g] * (f32x2){fmaxf(acc[8 + 2 * g], 0.f), fmaxf(acc[9 + 2 * g], 0.f)}; } \
        const float sc0 = sa.x + sa.y, sc1 = sb.x + sb.y; \
        const int key = (s0_) + r; \
        const unsigned pk0 = ordkey(sc0, key), pk1 = ordkey(sc1, key); \
        const unsigned tauA = hi ? tau2 : tau0, tauB = hi ? tau3 : tau1; \
        const bool p0 = (key <= tA) && (pk0 > tauA), p1 = (key <= tB) && (pk1 > tauB); \
        DSA_APPEND(p0, pk0, cnt0, cnt2, 0, 2); \
        DSA_APPEND(p1, pk1, cnt1, cnt3, 1, 3); } while (0)
    asm volatile("s_waitcnt lgkmcnt(0)" ::: "memory"); __builtin_amdgcn_s_barrier(); asm volatile("" ::: "memory");
    if (wave == 0 && lane < 3) vote[lane] = 0u;
    DSA_DMA(0, 0); DSA_DMA(nst > 1 ? 1 : 0, 1);
    int sl = 0;
#pragma unroll 1
    for (int st = 0; st < nst; ++st) {
        asm volatile("s_waitcnt vmcnt(1) lgkmcnt(0)" ::: "memory"); __builtin_amdgcn_s_barrier(); asm volatile("" ::: "memory");
        const int sl2 = (sl >= 1) ? sl - 1 : 2;
        DSA_DMA(st + 2 < nst ? st + 2 : nst - 1, sl2);
        const int vprev = (sl >= 1) ? sl - 1 : 2, vnext = (sl == 2) ? 0 : sl + 1;
        if (st > 0 && vote[vprev] != 0u) {
            if (cnt0 > TOPK + DSLACK) cnt0 = dsa_compact<DSLACK>(cw + 0 * DC, cnt0, lane, tau0);
            if (cnt1 > TOPK + DSLACK) cnt1 = dsa_compact<DSLACK>(cw + 1 * DC, cnt1, lane, tau1);
            if (cnt2 > TOPK + DSLACK) cnt2 = dsa_compact<DSLACK>(cw + 2 * DC, cnt2, lane, tau2);
            if (cnt3 > TOPK + DSLACK) cnt3 = dsa_compact<DSLACK>(cw + 3 * DC, cnt3, lane, tau3);
        }
        if (wave == 0 && lane == 0) vote[vnext] = 0u;
        const LAS unsigned char* sbase = ring + sl * DSA_SLOT;
        DSA_SUBTILE(sbase, st * 64);
        DSA_SUBTILE(sbase + 4096, st * 64 + 32);
        { const int c01 = cnt0 > cnt1 ? cnt0 : cnt1, c23 = cnt2 > cnt3 ? cnt2 : cnt3, cm = c01 > c23 ? c01 : c23;
          if (cm > DC - 64 && lane == 0) vote[sl] = 1u; }
        sl = (sl == 2) ? 0 : sl + 1;
    }
    asm volatile("s_waitcnt vmcnt(0)" ::: "memory");
#undef DSA_SUBTILE
#undef DSA_APPEND
#undef DSA_DMA
    if (cnt0 > TOPK) cnt0 = dsa_compact<0>(cw + 0 * DC, cnt0, lane, tau0);
    if (cnt1 > TOPK) cnt1 = dsa_compact<0>(cw + 1 * DC, cnt1, lane, tau1);
    if (cnt2 > TOPK) cnt2 = dsa_compact<0>(cw + 2 * DC, cnt2, lane, tau2);
    if (cnt3 > TOPK) cnt3 = dsa_compact<0>(cw + 3 * DC, cnt3, lane, tau3);
    const int fr = lane & 15, fq = lane >> 4;
#pragma unroll 1
    for (int q = 0; q < 4; ++q) {
        const int nsel = (q == 0) ? cnt0 : (q == 1) ? cnt1 : (q == 2) ? cnt2 : cnt3;
        const int t = t0 + q;
        const LAS unsigned* sel = cw + q * DC;
        bf16x8 Bq[4];
#pragma unroll
        for (int ks = 0; ks < 4; ++ks) { const bool ok = (fr < 8) && ((fr >> 2) == (ks >> 1));
            bf16x8 v = {0, 0, 0, 0, 0, 0, 0, 0};
            if (ok) v = *(const bf16x8*)(F.Q + (mb + t) * 512 + fr * 64 + (ks & 1) * 32 + fq * 8);
            Bq[ks] = v; }
        f32x4 lg[16];
        const LAS unsigned* selq = sel + fr;
#pragma unroll
        for (int T4 = 0; T4 < 16; T4 += 4) {
            bf16x8 kf[4][4];
#pragma unroll
            for (int tt = 0; tt < 4; ++tt) {
                const int sidx = (16 * (T4 + tt) < nsel - fr) ? (8191 - (int)(selq[16 * (T4 + tt)] & 0x1FFFu)) : 0;
                const bf16* kp = F.K + (mb + sidx) * 128 + fq * 8;
#pragma unroll
                for (int ks = 0; ks < 4; ++ks) kf[tt][ks] = *(const bf16x8*)(kp + ks * 32); }
#pragma unroll
            for (int tt = 0; tt < 4; ++tt) { f32x4 a4 = {0.f, 0.f, 0.f, 0.f};
#pragma unroll
                for (int ks = 0; ks < 4; ++ks) a4 = __builtin_amdgcn_mfma_f32_16x16x32_bf16(kf[tt][ks], Bq[ks], a4, 0, 0, 0);
                lg[T4 + tt] = a4; }
            asm volatile("" ::: "memory");
        }
        float mx = -INFINITY; const int nsq = nsel - 4 * fq;
#pragma unroll
        for (int T = 0; T < 16; ++T)
#pragma unroll
            for (int g = 0; g < 4; ++g) { const float xv = (16 * T + g < nsq) ? lg[T][g] * SM_SCALE_LOG2E : -INFINITY; lg[T][g] = xv; mx = fmaxf(mx, xv); }
        mx = fmaxf(mx, __shfl_xor(mx, 16)); mx = fmaxf(mx, __shfl_xor(mx, 32));
        float sm = 0.f;
#pragma unroll
        for (int T = 0; T < 16; ++T)
#pragma unroll
            for (int g = 0; g < 4; ++g) { const float p = __builtin_amdgcn_exp2f(lg[T][g] - mx); lg[T][g] = p; sm += p; }
        sm += __shfl_xor(sm, 16); sm += __shfl_xor(sm, 32);
        const float inv = 1.0f / sm;
        if (fr < 8) {
            LAS float* pwr = (LAS float*)cw + 32 * fq + fr;
#pragma unroll
            for (int T = 0; T < 16; ++T)
#pragma unroll
                for (int g = 0; g < 4; ++g) pwr[(T >> 2) * DC + 256 + (16 * (T & 3) + g) * 8] = lg[T][g] * inv;
        }
        const int g4 = fq, ch = fr, kh = ch >> 3;
        f32x2 oa[4][4];
#pragma unroll
        for (int h = 0; h < 4; ++h)
#pragma unroll
            for (int dp = 0; dp < 4; ++dp) oa[h][dp] = (f32x2){0.f, 0.f};
        const bf16* vb = F.V + mb * 128 + 8 * ch;
#pragma unroll 1
        for (int i0 = 0; i0 < 64; i0 += 16) {
            const LAS unsigned* selp = sel + 4 * i0 + g4;
            const LAS float* prd = (const LAS float*)cw + (i0 >> 4) * DC + 8 * g4 + 4 * kh;
            const int nrem = nsel - 4 * i0 - g4;
            v4u vv[16];
#pragma unroll
            for (int k = 0; k < 16; ++k) { const int sidx = (4 * k < nrem) ? (8191 - (int)(selp[4 * k] & 0x1FFFu)) : 0; vv[k] = *(const v4u*)(vb + (size_t)sidx * 128); }
#pragma unroll
            for (int k = 0; k < 16; ++k) {
                const f32x4 p = *(const LAS f32x4*)(prd + 256 + 32 * k);
                const f32x2 x0 = (f32x2){bf2f(vv[k].x & 0xffffu), __uint_as_float(vv[k].x & 0xffff0000u)}, x1 = (f32x2){bf2f(vv[k].y & 0xffffu), __uint_as_float(vv[k].y & 0xffff0000u)};
                const f32x2 x2 = (f32x2){bf2f(vv[k].z & 0xffffu), __uint_as_float(vv[k].z & 0xffff0000u)}, x3 = (f32x2){bf2f(vv[k].w & 0xffffu), __uint_as_float(vv[k].w & 0xffff0000u)};
#pragma unroll
                for (int h = 0; h < 4; ++h) { const f32x2 ph = (f32x2){p[h], p[h]}; oa[h][0] += ph * x0; oa[h][1] += ph * x1; oa[h][2] += ph * x2; oa[h][3] += ph * x3; } }
        }
#pragma unroll
        for (int h = 0; h < 4; ++h)
#pragma unroll
            for (int dp = 0; dp < 4; ++dp) { float a = oa[h][dp].x, c2 = oa[h][dp].y; a += __shfl_xor(a, 16); a += __shfl_xor(a, 32); c2 += __shfl_xor(c2, 16); c2 += __shfl_xor(c2, 32); oa[h][dp] = (f32x2){a, c2}; }
        if (lane < 16) {
            bf16* op = F.MIX + (mb + t) * D + (kh * 4) * 64 + 8 * (ch & 7);
#pragma unroll
            for (int h = 0; h < 4; ++h) { v4u o; o.x = pk2(oa[h][0].x, oa[h][0].y); o.y = pk2(oa[h][1].x, oa[h][1].y); o.z = pk2(oa[h][2].x, oa[h][2].y); o.w = pk2(oa[h][3].x, oa[h][3].y);
                *(v4u*)(op + h * 64) = o; }
        }
    }
}
__device__ __forceinline__ void p4_dsa(Frame& F) {
    int lane = threadIdx.x & 63; asm volatile("" : "+v"(lane));
    for (int w = F.vcu; w < 256; w += F.G) {
        const int b = w >> 6, j = w & 63;
#pragma unroll 1
        for (int k = 0; k < 4; ++k) { const int u = (k == 0) ? j : (k == 1) ? 127 - j : (k == 2) ? 128 + j : 255 - j; dsa_unit(F, lane, F.wave, b, u); }
    }
    __syncthreads();
}

struct Args { const void* in[16]; float* out; unsigned char* ws; };
__global__ void __launch_bounds__(NWAVES * 64, 2) fwd_kernel(Args args) {
    extern __shared__ __attribute__((aligned(16))) unsigned char lds[];
    Frame F;
    F.lds = (LAS unsigned char*)lds;
    F.MISC = (volatile LAS unsigned*)(F.lds + MISC_OFF);
    F.tid = threadIdx.x; F.lane = F.tid & 63; F.wave = __builtin_amdgcn_readfirstlane(F.tid >> 6);
    F.G = gridDim.x; { const int bx = blockIdx.x; F.vcu = (F.G % 8 == 0) ? (bx % 8) * (F.G / 8) + bx / 8 : bx; }
    unsigned char* ws = args.ws;
    F.ctl = (gu32*)(ws + WS_CTL);
    F.x = (const float*)args.in[0]; F.c = (const float*)args.in[1]; F.positions = (const int*)args.in[2]; F.w_ada = (const float*)args.in[3]; F.b_ada = (const float*)args.in[4];
    F.g_mix = (const float*)args.in[5]; F.w_in = (const float*)args.in[6]; F.conv_w = (const float*)args.in[7]; F.conv_b = (const float*)args.in[8]; F.conv_ng = (const float*)args.in[9];
    F.conv_nb = (const float*)args.in[10]; F.w_out = (const float*)args.in[11]; F.g_mlp = (const float*)args.in[12]; F.w_up = (const float*)args.in[13]; F.w_down = (const float*)args.in[14];
    F.g_final = (const float*)args.in[15]; F.out = args.out;
    F.Win_t = (bf16*)(ws + WS_WIN); F.Wout_t = (bf16*)(ws + WS_WOUT); F.Wup_t = (bf16*)(ws + WS_WUP); F.Wdn_t = (bf16*)(ws + WS_WDN);
    F.mod = (float*)(ws + WS_MOD); F.CS = (float*)(ws + WS_CS); F.WI = (float*)(ws + WS_WI);
    F.H = (bf16*)(ws + WS_H); F.PROJ = (bf16*)(ws + WS_PROJ); F.Q = (bf16*)(ws + WS_Q); F.K = (bf16*)(ws + WS_K); F.V = (bf16*)(ws + WS_V); F.QI = (bf16*)(ws + WS_QI);
    F.KI = (bf16*)(ws + WS_KI); F.GLU = (bf16*)(ws + WS_GLU); F.MIX = (bf16*)(ws + WS_MIX); F.U = (bf16*)(ws + WS_U);
    for (int u = F.tid; u < (LDS_BYTES - LDSCTL_OFF) / 4; u += NWAVES * 64) ((LAS unsigned*)(F.lds + LDSCTL_OFF))[u] = 0u;
    __syncthreads();
    XcdBarrier bar = xcd_barrier_post((unsigned*)(F.ctl + CW_BAR), F.MISC + 8);
#define GRID_BAR() xcd_barrier(bar)
    const float* sh1 = F.mod, *sc1 = F.mod + D, *gt1 = F.mod + 2 * D, *sh2 = F.mod + 3 * D, *sc2 = F.mod + 4 * D, *gt2 = F.mod + 5 * D;

    p0_prologue(F); GRID_BAR();
    normmod_rows(F, F.x, F.g_mix, sh1, sc1, F.H); GRID_BAR();
    { pg8::Gemm g{F.H, F.Win_t, M, DINP, D}; pg8::StaticOrder So; So.init(M, DINP, F.G, (int)blockIdx.x);
      pg8::EpiBf16<0> E{F.PROJ, DINP, nullptr, 0, 0, 1.f};
      pg8::gemm_phase<pg8::EpiBf16<0>, pg8::StaticOrder, true, true>(F.lds + RING_OFF, g, So, E); }
    GRID_BAR();
    p3_post(F); GRID_BAR();
    p4_conv(F); p4_dsa(F); GRID_BAR();
    { pg8::Gemm g{F.MIX, F.Wout_t, M, D, D}; pg8::StaticOrder So; So.init(M, D, F.G, (int)blockIdx.x);
      pg8::EpiResGate E{F.x, F.out, D, gt1, MODW, S};
      pg8::gemm_phase<pg8::EpiResGate, pg8::StaticOrder, true, true>(F.lds + RING_OFF, g, So, E); }
    GRID_BAR();
    normmod_rows(F, F.out, F.g_mlp, sh2, sc2, F.H); GRID_BAR();
    { pg8::Gemm g{F.H, F.Wup_t, M, FF, D}; pg8::StaticOrder So; So.init(M, FF, F.G, (int)blockIdx.x);
      pg8::EpiBf16<2> E{F.U, FF, nullptr, 0, 0, 1.f};
      pg8::gemm_phase<pg8::EpiBf16<2>, pg8::StaticOrder, true, true>(F.lds + RING_OFF, g, So, E); }
    GRID_BAR();
    { pg8::Gemm g{F.U, F.Wdn_t, M, D, FF}; pg8::StaticOrder So; So.init(M, D, F.G, (int)blockIdx.x);
      pg8::EpiResGate E{F.out, F.out, D, gt2, MODW, S};
      pg8::gemm_phase<pg8::EpiResGate, pg8::StaticOrder, true, true>(F.lds + RING_OFF, g, So, E); }
    GRID_BAR();
    final_norm_rows(F, F.out, F.g_final);
#undef GRID_BAR
}

extern "C" void kernel_launch(void* const* d_in, const int* in_sizes, int n_in, void* d_out, int out_size, void* d_ws, size_t ws_size, hipStream_t stream) {
    static int grid = 0;
    if (grid == 0) {
        if (n_in != 16 || in_sizes[0] != M * D || out_size != M * D || ws_size < WS_END) { fprintf(stderr, "kernel_launch: unexpected shapes (n_in %d, in0 %d, out %d, ws %zu); nothing launched\n", n_in, n_in > 0 ? in_sizes[0] : -1, out_size, ws_size); grid = -1; return; }
        int dev = 0, cus = 0, per_cu = 0;
        if (hipGetDevice(&dev) != hipSuccess || hipDeviceGetAttribute(&cus, hipDeviceAttributeMultiprocessorCount, dev) != hipSuccess) { grid = -1; return; }
        if (hipFuncSetAttribute((const void*)fwd_kernel, hipFuncAttributeMaxDynamicSharedMemorySize, LDS_BYTES) != hipSuccess) { fprintf(stderr, "kernel_launch: hipFuncSetAttribute failed\n"); grid = -1; return; }
        if (hipOccupancyMaxActiveBlocksPerMultiprocessor(&per_cu, (const void*)fwd_kernel, NWAVES * 64, LDS_BYTES) != hipSuccess || per_cu < 1) { fprintf(stderr, "kernel_launch: occupancy query says %d blocks per CU; nothing launched\n", per_cu); (void)hipGetLastError(); grid = -1; return; }
        grid = cus;
    }
    if (grid < 0) return;
    if (hipMemsetAsync((char*)d_ws + WS_CTL, 0, CTL_ZERO_BYTES, stream) != hipSuccess) { fprintf(stderr, "kernel_launch: memset failed\n"); return; }
    Args a{};
    for (int i = 0; i < 16; ++i) a.in[i] = d_in[i];
    a.out = (float*)d_out; a.ws = (unsigned char*)d_ws;
    hipLaunchKernelGGL(fwd_kernel, dim3(grid), dim3(NWAVES * 64), LDS_BYTES, stream, a);
}
```

```cpp
#include <cmath>
#include <hip/hip_runtime.h>
#include <cstdio>
#include <cstdint>
namespace pg8 {
#define PG8_LAS __attribute__((address_space(3)))
typedef unsigned short bf16_t;
typedef short bf16x8 __attribute__((ext_vector_type(8)));
typedef float f32x4 __attribute__((ext_vector_type(4)));
typedef unsigned u32x4 __attribute__((ext_vector_type(4)));
constexpr int BM = 256, BK = 64, HALF = 128, HTB = HALF * BK * 2  , STAGE_BYTES = 8 * HTB, NXCD = 8, WGM = 8;

__host__ __device__ __forceinline__ int lds_byte(int r, int c) { const int st = (r >> 4) * 2 + (c >> 5), rr = r & 15, cc = c & 31, ob = rr * 64 + cc * 2; return st * 1024 + (ob ^ (((ob >> 9) & 1) << 5)); }
__host__ __device__ __forceinline__ void stage_rc(int b, int& R, int& C) { const int st = b / 1024, sb = b % 1024, swz = sb ^ (((sb >> 9) & 1) << 5); R = (st >> 1) * 16 + swz / 64; C = (st & 1) * 32 + (swz % 64) / 2; }
__host__ __device__ __forceinline__ int perm32(int rho) { const int n = rho >> 4, i = rho & 15; return 8 * (i >> 2) + 4 * n + (i & 3); }

struct Unit { int pm, pn; };
struct Gemm { const bf16_t* A; const bf16_t* Bt; int M, N, K; };

struct StaticOrder {
    int nM, nN, nwg, G, c;
    __host__ __device__ void init(int M, int N, int G_, int c_) { nM = M / BM; nN = N / BM; nwg = nM * nN; G = G_; c = c_; }
    __host__ __device__ bool next(int i, Unit& u) const {
        const long L = (long)i * G + c; if (L >= nwg) return false;
        int wgid = (int)L; { const int q = nwg / NXCD, r = nwg % NXCD, xcd = wgid % NXCD, off = wgid / NXCD; wgid = (xcd < r ? xcd * (q + 1) : r * (q + 1) + (xcd - r) * q) + off; }
        const int nig = WGM * nN, gid = wgid / nig, fm = gid * WGM, gsz = (nM - fm) < WGM ? (nM - fm) : WGM;
        u.pm = fm + ((wgid % nig) % gsz); u.pn = (wgid % nig) / gsz; return true;
    }
    __device__ __forceinline__ void a_ready(const Unit&) const {}
    __device__ __forceinline__ void done(const Unit&) const {}
};

__device__ __forceinline__ unsigned cvt_pk_bf16(float lo, float hi) { unsigned r; asm volatile("v_cvt_pk_bf16_f32 %0, %1, %2" : "=v"(r) : "v"(lo), "v"(hi)); return r; }
typedef float f32x2 __attribute__((ext_vector_type(2)));
__device__ __forceinline__ f32x2 gelu_pk(f32x2 v) {
    const f32x2 av = __builtin_elementwise_abs(v), d = av * 0.2316418882f + 1.0f;
    f32x2 t; t.x = __builtin_amdgcn_rcpf(d.x); t.y = __builtin_amdgcn_rcpf(d.y);
    f32x2 q = t * 0.5307027145f + (-0.7265760135f); q = q * t + 0.7107068705f; q = q * t + (-0.142248368f); q = q * t + 0.127414796f; q = q * t;
    const f32x2 s = (v * v) * (-0.72134752044f);
    f32x2 e; e.x = __builtin_amdgcn_exp2f(s.x); e.y = __builtin_amdgcn_exp2f(s.y);
    const f32x2 m = v * (q * e), r = v - m;
    f32x2 o; o.x = v.x < 0.f ? m.x : r.x; o.y = v.y < 0.f ? m.y : r.y; return o;
}

template <int ACT  > struct EpiBf16 {
    static constexpr bool PERM = true, AFTER_DRAIN = false; static_assert(ACT == 0 || ACT == 1 || ACT == 2, "EpiBf16: ACT is 0 (none), 1 (gelu_pk) or 2 (squared relu)");
    bf16_t* O; int ldc; const float* bias; int split_cols; size_t split_stride; float scale0;
    __device__ __forceinline__ void operator()(const f32x4 (&acc)[2][2][4][2], const Unit& u, int wr, int wc, int fr, int fq) const {
        const int row0 = u.pm * BM + wr * 64 + fr; int colt = u.pn * BM; bf16_t* base = O;
        float sc = 1.f; if (split_cols) { const int t = colt / split_cols; base += (size_t)t * split_stride; colt -= t * split_cols; if (t == 0) sc = scale0; }
        const int col0 = colt + wc * 32 + 8 * fq, bcol0 = u.pn * BM + wc * 32 + 8 * fq;
        f32x4 bv[2][2];
#pragma unroll
        for (int bj = 0; bj < 2; ++bj)
#pragma unroll
            for (int n = 0; n < 2; ++n) bv[bj][n] = bias ? *(const f32x4*)(bias + bcol0 + bj * HALF + 4 * n) : (f32x4){0.f, 0.f, 0.f, 0.f};
#pragma unroll
        for (int ai = 0; ai < 2; ++ai)
#pragma unroll
            for (int m = 0; m < 4; ++m) { bf16_t* rowp = base + (size_t)(row0 + ai * HALF + m * 16) * ldc + col0;
#pragma unroll
                for (int bj = 0; bj < 2; ++bj) { f32x4 v0 = acc[ai][bj][m][0] + bv[bj][0], v1 = acc[ai][bj][m][1] + bv[bj][1];
                    if (ACT == 1) { f32x2 a = gelu_pk((f32x2){v0[0], v0[1]}), b = gelu_pk((f32x2){v0[2], v0[3]}), c = gelu_pk((f32x2){v1[0], v1[1]}), d = gelu_pk((f32x2){v1[2], v1[3]});
                        v0 = (f32x4){a.x, a.y, b.x, b.y}; v1 = (f32x4){c.x, c.y, d.x, d.y}; }
                    if (ACT == 2) { v0 = __builtin_elementwise_max(v0, (f32x4){0.f, 0.f, 0.f, 0.f}); v1 = __builtin_elementwise_max(v1, (f32x4){0.f, 0.f, 0.f, 0.f}); v0 = v0 * v0; v1 = v1 * v1; }
                    v0 = v0 * sc; v1 = v1 * sc; u32x4 w; w.x = cvt_pk_bf16(v0[0], v0[1]); w.y = cvt_pk_bf16(v0[2], v0[3]); w.z = cvt_pk_bf16(v1[0], v1[1]); w.w = cvt_pk_bf16(v1[2], v1[3]);
                    *(u32x4*)(rowp + bj * HALF) = w; } }
    }
};


struct EpiResGate {
    static constexpr bool PERM = true, AFTER_DRAIN = false;
    const float* base; float* out; int ldc; const float* gate; int gate_stride; int rows_per_batch;
    __device__ __forceinline__ void operator()(const f32x4 (&acc)[2][2][4][2], const Unit& u, int wr, int wc, int fr, int fq) const {
        const int row0 = u.pm * BM + wr * 64 + fr, col0 = u.pn * BM + wc * 32 + 8 * fq;
        const float* gp = gate + (size_t)((u.pm * BM) / rows_per_batch) * gate_stride + col0;
        f32x4 gv[2][2];
#pragma unroll
        for (int bj = 0; bj < 2; ++bj)
#pragma unroll
            for (int n = 0; n < 2; ++n) gv[bj][n] = *(const f32x4*)(gp + bj * HALF + n * 4);
#pragma unroll
        for (int ai = 0; ai < 2; ++ai)
#pragma unroll
            for (int m = 0; m < 4; ++m) { const size_t off = (size_t)(row0 + ai * HALF + m * 16) * ldc + col0;
#pragma unroll
                for (int bj = 0; bj < 2; ++bj)
#pragma unroll
                    for (int n = 0; n < 2; ++n) { const f32x4 bs = *(const f32x4*)(base + off + bj * HALF + n * 4); *(f32x4*)(out + off + bj * HALF + n * 4) = bs + gv[bj][n] * acc[ai][bj][m][n]; }
                if (m & 1) asm volatile("" ::: "memory"); }
    }
};

struct EpiProj {
    static constexpr bool PERM = true, AFTER_DRAIN = false;
    bf16_t *Q, *K, *V, *QI, *KI, *GLU; float* WI; const float* CS; float wi_scale;
    __device__ __forceinline__ static float sigm(float g) { return 1.0f / (1.0f + __expf(-g)); }
    __device__ __forceinline__ void operator()(const f32x4 (&acc)[2][2][4][2], const Unit& u, int wr, int wc, int fr, int fq) const {
        const int pn = u.pn;
        const int lane_ = fr + 16 * fq;
#pragma unroll
        for (int ai = 0; ai < 2; ++ai)
#pragma unroll
            for (int m = 0; m < 4; ++m) {
                const size_t row = (size_t)u.pm * BM + ai * HALF + wr * 64 + m * 16 + fr;
                if (pn >= 6) {
                    const f32x4 a0 = acc[ai][0][m][0], a1 = acc[ai][0][m][1], g0 = acc[ai][1][m][0], g1 = acc[ai][1][m][1];
                    u32x4 w; w.x = cvt_pk_bf16(a0[0] * sigm(g0[0]), a0[1] * sigm(g0[1])); w.y = cvt_pk_bf16(a0[2] * sigm(g0[2]), a0[3] * sigm(g0[3]));
                    w.z = cvt_pk_bf16(a1[0] * sigm(g1[0]), a1[1] * sigm(g1[1])); w.w = cvt_pk_bf16(a1[2] * sigm(g1[2]), a1[3] * sigm(g1[3]));
                    *(u32x4*)(GLU + row * 512 + 128 * (pn - 6) + 32 * wc + 8 * fq) = w;
                } else {
                    const f32x4 c0 = *(const f32x4*)(CS + row * 16), c1 = *(const f32x4*)(CS + row * 16 + 4), s0 = *(const f32x4*)(CS + row * 16 + 8), s1 = *(const f32x4*)(CS + row * 16 + 12);
#pragma unroll
                    for (int bj = 0; bj < 2; ++bj) {
                        f32x4 v0 = acc[ai][bj][m][0], v1 = acc[ai][bj][m][1];
                        const int col = 128 * bj + 32 * wc + 8 * fq;
                        const bool isv = (pn == 2 && bj == 1);
                        const bool dead = (pn == 5) && (bj == 1 || wc == 3 || (wc == 2 && fq != 0));
                        const bool iswi = (pn == 5) && bj == 0 && wc == 2;
                        const bool rot_grp = !isv && !iswi && !(pn == 5 && bj == 1) && ((wc & 1) == 0);
                        if (rot_grp) {
                            f32x4 p0, p1;
#pragma unroll
                            for (int j = 0; j < 4; ++j) { p0[j] = __shfl_xor(v0[j], 16); p1[j] = __shfl_xor(v1[j], 16); }
                            if (fq == 0) { v0 = v0 * c0 - p0 * s0; v1 = v1 * c1 - p1 * s1; }
                            else if (fq == 1) { v0 = v0 * c0 + p0 * s0; v1 = v1 * c1 + p1 * s1; }
                        }
                        if (dead) continue;
                        if (iswi) { if (fq == 0) { *(f32x4*)(WI + row * 8) = v0 * wi_scale; *(f32x4*)(WI + row * 8 + 4) = v1 * wi_scale; } continue; }
                        u32x4 w; w.x = cvt_pk_bf16(v0[0], v0[1]); w.y = cvt_pk_bf16(v0[2], v0[3]); w.z = cvt_pk_bf16(v1[0], v1[1]); w.w = cvt_pk_bf16(v1[2], v1[3]);
                        bf16_t* dst;
                        if (pn < 2) dst = Q + row * 512 + 256 * pn + col;
                        else if (pn == 2) dst = (bj == 0 ? K : V) + row * 128 + (col - 128 * bj);
                        else if (pn < 5) dst = QI + row * 512 + 256 * (pn - 3) + col;
                        else dst = KI + row * 64 + col;
                        *(u32x4*)dst = w;
                    }
                }
            }
        (void)lane_;
    }
};

struct EpiResGateA2 {
    static constexpr bool PERM = true, AFTER_DRAIN = false;
    const float* base; float* out; int ldc; const float* gate; const float* sc2; const float* gmlp; int mod_stride; int rows_per_batch; bf16_t* A2; float* part;
    __device__ __forceinline__ void operator()(const f32x4 (&acc)[2][2][4][2], const Unit& u, int wr, int wc, int fr, int fq) const {
        const int row0 = u.pm * BM + wr * 64 + fr, col0 = u.pn * BM + wc * 32 + 8 * fq;
        const size_t mo = (size_t)((u.pm * BM) / rows_per_batch) * mod_stride + col0;
        f32x4 gv[2][2], gs[2][2];
#pragma unroll
        for (int bj = 0; bj < 2; ++bj)
#pragma unroll
            for (int n = 0; n < 2; ++n) { gv[bj][n] = *(const f32x4*)(gate + mo + bj * HALF + n * 4);
                gs[bj][n] = *(const f32x4*)(gmlp + col0 + bj * HALF + n * 4) * (*(const f32x4*)(sc2 + mo + bj * HALF + n * 4) + 1.0f); }
#pragma unroll
        for (int ai = 0; ai < 2; ++ai)
#pragma unroll
            for (int m = 0; m < 4; ++m) { const size_t row = (size_t)(row0 + ai * HALF + m * 16); const size_t off = row * ldc + col0; float ss = 0.f;
#pragma unroll
                for (int bj = 0; bj < 2; ++bj) { f32x4 a[2];
#pragma unroll
                    for (int n = 0; n < 2; ++n) { const f32x4 bs = *(const f32x4*)(base + off + bj * HALF + n * 4); const f32x4 x1 = bs + gv[bj][n] * acc[ai][bj][m][n];
                        *(f32x4*)(out + off + bj * HALF + n * 4) = x1; ss += (x1[0] * x1[0] + x1[1] * x1[1]) + (x1[2] * x1[2] + x1[3] * x1[3]); a[n] = x1 * gs[bj][n]; }
                    u32x4 w; w.x = cvt_pk_bf16(a[0][0], a[0][1]); w.y = cvt_pk_bf16(a[0][2], a[0][3]); w.z = cvt_pk_bf16(a[1][0], a[1][1]); w.w = cvt_pk_bf16(a[1][2], a[1][3]);
                    *(u32x4*)(A2 + off + bj * HALF) = w; }
                ss += __shfl_xor(ss, 16); ss += __shfl_xor(ss, 32);
                if (fq == 0) part[row * 16 + u.pn * 4 + wc] = ss;
                if (m & 1) asm volatile("" ::: "memory"); }
    }
};
struct EpiUp {
    static constexpr bool PERM = true, AFTER_DRAIN = false;
    bf16_t* O; int ldc; const float* bias2; int bias_stride; int rows_per_batch; const float* part; float inv_n, eps;
    __device__ __forceinline__ void operator()(const f32x4 (&acc)[2][2][4][2], const Unit& u, int wr, int wc, int fr, int fq) const {
        const int row0 = u.pm * BM + wr * 64 + fr, col0 = u.pn * BM + wc * 32 + 8 * fq;
        const float* bp = bias2 + (size_t)((u.pm * BM) / rows_per_batch) * bias_stride + col0;
        f32x4 bv[2][2];
#pragma unroll
        for (int bj = 0; bj < 2; ++bj)
#pragma unroll
            for (int n = 0; n < 2; ++n) bv[bj][n] = *(const f32x4*)(bp + bj * HALF + 4 * n);
#pragma unroll
        for (int ai = 0; ai < 2; ++ai)
#pragma unroll
            for (int m = 0; m < 4; ++m) { const size_t row = (size_t)(row0 + ai * HALF + m * 16);
                const f32x4 p0 = *(const f32x4*)(part + row * 16), p1 = *(const f32x4*)(part + row * 16 + 4), p2 = *(const f32x4*)(part + row * 16 + 8), p3 = *(const f32x4*)(part + row * 16 + 12);
                const float ssum = (((p0[0] + p0[1]) + (p0[2] + p0[3])) + ((p1[0] + p1[1]) + (p1[2] + p1[3]))) + (((p2[0] + p2[1]) + (p2[2] + p2[3])) + ((p3[0] + p3[1]) + (p3[2] + p3[3])));
                const float rinv = 1.0f / sqrtf(ssum * inv_n + eps);
                bf16_t* rowp = O + row * ldc + col0;
#pragma unroll
                for (int bj = 0; bj < 2; ++bj) { f32x4 v0 = acc[ai][bj][m][0] * rinv + bv[bj][0], v1 = acc[ai][bj][m][1] * rinv + bv[bj][1];
                    v0 = __builtin_elementwise_max(v0, (f32x4){0.f, 0.f, 0.f, 0.f}); v1 = __builtin_elementwise_max(v1, (f32x4){0.f, 0.f, 0.f, 0.f}); v0 = v0 * v0; v1 = v1 * v1;
                    u32x4 w; w.x = cvt_pk_bf16(v0[0], v0[1]); w.y = cvt_pk_bf16(v0[2], v0[3]); w.z = cvt_pk_bf16(v1[0], v1[1]); w.w = cvt_pk_bf16(v1[2], v1[3]);
                    *(u32x4*)(rowp + bj * HALF) = w; } }
    }
};

template <class Epi, class Sched, bool ALIGN_EPI = false, bool SP2 = false>
__device__ __forceinline__ void gemm_phase(PG8_LAS unsigned char* lds, const Gemm g, const Sched& S, const Epi& E) {
    int tid_ = threadIdx.x; asm volatile("" : "+v"(tid_));
    const int tid = tid_, wid = __builtin_amdgcn_readfirstlane(tid >> 6), lane = tid & 63, wr = wid >> 2, wc = wid & 3, fr = lane & 15, fq = lane >> 4;
    const int K = g.K, nt = K / BK;
    unsigned voffA[2], voffB[2];
#pragma unroll
    for (int i = 0; i < 2; ++i) { int R, C; stage_rc(tid * 16 + i * 8192, R, C); const int Rb = Epi::PERM ? ((R & ~31) + perm32(R & 31)) : R;
        voffA[i] = (unsigned)(R * K + C) * 2u; voffB[i] = (unsigned)(Rb * K + C) * 2u; }
    const size_t kstep = (size_t)(BK * 2);
    const size_t hstep = (size_t)HALF * K * 2;
    const size_t tstep = 2 * hstep;
    const unsigned ldsw = (unsigned)wid * 1024u;
    const int aoff = lds_byte(wr * 64 + fr, fq * 8), boff = lds_byte(wc * 32 + fr, fq * 8);
#define PG8_SA(b, h) (((b) * 2 + (h)) * HTB)
#define PG8_SB(b, h) ((4 + (b) * 2 + (h)) * HTB)
#define PG8_STAGE(bufoff, gbase, voff) do { _Pragma("unroll") for (int _i = 0; _i < 2; ++_i) \
        __builtin_amdgcn_global_load_lds((const unsigned*)((const char*)(gbase) + (voff)[_i]), (PG8_LAS unsigned*)(lds + (bufoff) + ldsw + _i * 8192), 16, 0, 0); } while (0)
#define PG8_LDA(dst, b, h) do { _Pragma("unroll") for (int m = 0; m < 4; ++m) _Pragma("unroll") for (int k = 0; k < 2; ++k) dst[m][k] = *(const PG8_LAS bf16x8*)(lds + PG8_SA(b, h) + aoff + m * 2048 + k * 1024); } while (0)
#define PG8_LDB(dst, b, h) do { _Pragma("unroll") for (int n = 0; n < 2; ++n) _Pragma("unroll") for (int k = 0; k < 2; ++k) dst[n][k] = *(const PG8_LAS bf16x8*)(lds + PG8_SB(b, h) + boff + n * 2048 + k * 1024); } while (0)
#define PG8_MMA(ai, bj, At, Bt) do { __builtin_amdgcn_s_setprio(1); _Pragma("unroll") for (int m = 0; m < 4; ++m) _Pragma("unroll") for (int n = 0; n < 2; ++n) _Pragma("unroll") for (int k = 0; k < 2; ++k) \
        acc[ai][bj][m][n] = __builtin_amdgcn_mfma_f32_16x16x32_bf16(Bt[n][k], At[m][k], acc[ai][bj][m][n], 0, 0, 0); __builtin_amdgcn_s_setprio(0); } while (0)
#define PG8_WAIT_V(n) asm volatile("s_waitcnt vmcnt(" #n ")" ::: "memory")
#define PG8_WAIT_L(n) asm volatile("s_waitcnt lgkmcnt(" #n ")" ::: "memory")
#define PG8_BAR __builtin_amdgcn_s_barrier()
#define PG8_SCHED __builtin_amdgcn_sched_barrier(0)
    Unit cur, nxt; int ui = 0;
    if (!S.next(0, cur)) return;
    f32x4 acc[2][2][4][2];
#pragma unroll
    for (int a = 0; a < 2; ++a)
#pragma unroll
        for (int b = 0; b < 2; ++b)
#pragma unroll
            for (int m = 0; m < 4; ++m)
#pragma unroll
                for (int n = 0; n < 2; ++n) acc[a][b][m][n] = (f32x4){0.f, 0.f, 0.f, 0.f};
    bf16x8 At[4][2], B0[2][2], B1[2][2];
    const char* cA = (const char*)g.A + (size_t)cur.pm * tstep; const char* cB = (const char*)g.Bt + (size_t)cur.pn * tstep;
    S.a_ready(cur);
    if constexpr (SP2) {
        PG8_STAGE(PG8_SB(0, 0), cB, voffB); PG8_STAGE(PG8_SB(0, 1), cB + hstep, voffB); PG8_STAGE(PG8_SA(0, 0), cA, voffA); PG8_STAGE(PG8_SA(0, 1), cA + hstep, voffA);
        if (wr == 1) PG8_BAR;
        PG8_WAIT_V(2); PG8_BAR;
        PG8_STAGE(PG8_SB(1, 0), cB + kstep, voffB); PG8_STAGE(PG8_SA(1, 0), cA + kstep, voffA); PG8_STAGE(PG8_SB(1, 1), cB + hstep + kstep, voffB);
        PG8_WAIT_V(6); PG8_BAR;
    } else {
        PG8_STAGE(PG8_SB(0, 0), cB, voffB); PG8_STAGE(PG8_SA(0, 0), cA, voffA); PG8_STAGE(PG8_SB(0, 1), cB + hstep, voffB); PG8_STAGE(PG8_SA(0, 1), cA + hstep, voffA);
        if (wr == 1) PG8_BAR;
        PG8_WAIT_V(4); PG8_BAR;
        PG8_STAGE(PG8_SB(1, 0), cB + kstep, voffB); PG8_STAGE(PG8_SA(1, 0), cA + kstep, voffA); PG8_STAGE(PG8_SB(1, 1), cB + hstep + kstep, voffB);
        PG8_WAIT_V(6); PG8_BAR;
    }
    for (;;) {
        const bool has_next = S.next(ui + 1, nxt);
        const char* nA = has_next ? (const char*)g.A + (size_t)nxt.pm * tstep : cA; const char* nB = has_next ? (const char*)g.Bt + (size_t)nxt.pn * tstep : cB;
        for (int t = 0; t < nt; t += 2) {
            const bool last = (t == nt - 2);
            const char* a1 = cA + (size_t)(t + 1) * kstep;
            const char* a2 = last ? nA : cA + (size_t)(t + 2) * kstep; const char* b2 = last ? nB : cB + (size_t)(t + 2) * kstep;
            const char* a3 = a2 + kstep; const char* b3 = b2 + kstep;
            if (last && has_next) S.a_ready(nxt);
            if constexpr (SP2) {
            PG8_LDB(B0, 0, 0); PG8_LDB(B1, 0, 1); PG8_SCHED; PG8_LDA(At, 0, 0); PG8_STAGE(PG8_SA(1, 1), a1 + hstep, voffA);
            PG8_WAIT_V(8); PG8_WAIT_L(0); PG8_BAR; PG8_MMA(0, 0, At, B0); PG8_MMA(0, 1, At, B1); PG8_BAR; PG8_SCHED;
            PG8_LDA(At, 0, 1); PG8_STAGE(PG8_SB(0, 0), b2, voffB); PG8_STAGE(PG8_SB(0, 1), b2 + hstep, voffB); PG8_STAGE(PG8_SA(0, 0), a2, voffA);
            PG8_WAIT_V(8); PG8_WAIT_L(0); PG8_BAR; PG8_MMA(1, 0, At, B0); PG8_MMA(1, 1, At, B1); PG8_BAR; PG8_SCHED;
            PG8_LDB(B0, 1, 0); PG8_LDB(B1, 1, 1); PG8_SCHED; PG8_LDA(At, 1, 0); PG8_STAGE(PG8_SA(0, 1), a2 + hstep, voffA);
            PG8_WAIT_V(8); PG8_WAIT_L(0); PG8_BAR; PG8_MMA(0, 0, At, B0); PG8_MMA(0, 1, At, B1); PG8_BAR; PG8_SCHED;
            PG8_LDA(At, 1, 1); PG8_STAGE(PG8_SB(1, 0), b3, voffB); PG8_STAGE(PG8_SB(1, 1), b3 + hstep, voffB); PG8_STAGE(PG8_SA(1, 0), a3, voffA);
            PG8_WAIT_V(8); PG8_WAIT_L(0); PG8_BAR; PG8_MMA(1, 0, At, B0); PG8_MMA(1, 1, At, B1); PG8_BAR; PG8_SCHED;
            } else {
            PG8_LDB(B0, 0, 0); PG8_SCHED; PG8_LDA(At, 0, 0); PG8_STAGE(PG8_SA(1, 1), a1 + hstep, voffA);
            PG8_WAIT_L(8); PG8_BAR; PG8_WAIT_L(0); PG8_MMA(0, 0, At, B0); PG8_BAR; PG8_SCHED;
            PG8_LDB(B1, 0, 1); PG8_STAGE(PG8_SB(0, 0), b2, voffB);
            PG8_BAR; PG8_WAIT_L(0); PG8_MMA(0, 1, At, B1); PG8_BAR;
            PG8_LDA(At, 0, 1); PG8_STAGE(PG8_SA(0, 0), a2, voffA);
            PG8_BAR; PG8_WAIT_L(0); PG8_MMA(1, 0, At, B0); PG8_BAR; PG8_SCHED;
            PG8_STAGE(PG8_SB(0, 1), b2 + hstep, voffB);
            PG8_WAIT_V(6); PG8_BAR; PG8_MMA(1, 1, At, B1); PG8_BAR;
            PG8_LDB(B0, 1, 0); PG8_SCHED; PG8_LDA(At, 1, 0); PG8_STAGE(PG8_SA(0, 1), a2 + hstep, voffA);
            PG8_WAIT_L(8); PG8_BAR; PG8_WAIT_L(0); PG8_MMA(0, 0, At, B0); PG8_BAR; PG8_SCHED;
            PG8_LDB(B1, 1, 1); PG8_STAGE(PG8_SB(1, 0), b3, voffB);
            PG8_BAR; PG8_WAIT_L(0); PG8_MMA(0, 1, At, B1); PG8_BAR;
            PG8_LDA(At, 1, 1); PG8_STAGE(PG8_SA(1, 0), a3, voffA);
            PG8_BAR; PG8_WAIT_L(0); PG8_MMA(1, 0, At, B0); PG8_BAR; PG8_SCHED;
            PG8_STAGE(PG8_SB(1, 1), b3 + hstep, voffB);
            PG8_WAIT_V(6); PG8_BAR; PG8_MMA(1, 1, At, B1); PG8_BAR;
            }
        }
        if constexpr (ALIGN_EPI) { if (wr == 0) PG8_BAR; }
        if constexpr (!Epi::AFTER_DRAIN) { E(acc, cur, wr, wc, fr, fq); S.done(cur); }
        if (!has_next) break;
#pragma unroll
        for (int a = 0; a < 2; ++a)
#pragma unroll
            for (int b = 0; b < 2; ++b)
#pragma unroll
                for (int m = 0; m < 4; ++m)
#pragma unroll
                    for (int n = 0; n < 2; ++n) acc[a][b][m][n] = (f32x4){0.f, 0.f, 0.f, 0.f};
        cur = nxt; cA = nA; cB = nB; ++ui;
        if constexpr (ALIGN_EPI) { if (wr == 1) PG8_BAR; }
    }
    PG8_WAIT_V(0);
    if constexpr (!ALIGN_EPI) { if (wr == 0) PG8_BAR; }
    PG8_BAR;
    if constexpr (Epi::AFTER_DRAIN) { E.fused(acc, cur, wr, wc, fr, fq, lds, wid, lane); S.done(cur); }
#undef PG8_SA
#undef PG8_SB
#undef PG8_STAGE
#undef PG8_LDA
#undef PG8_LDB
#undef PG8_MMA
#undef PG8_WAIT_V
#undef PG8_WAIT_L
#undef PG8_BAR
#undef PG8_SCHED
}
}

#ifndef PG8_SP2
#define PG8_SP2 true
#endif
#ifndef PG8_ALIGN
#define PG8_ALIGN true
#endif
#define GAS __attribute__((address_space(1)))
#define LAS __attribute__((address_space(3)))
typedef unsigned short bf16;
typedef unsigned v4u __attribute__((ext_vector_type(4)));
typedef float f32x4 __attribute__((ext_vector_type(4)));
typedef short bf16x8 __attribute__((ext_vector_type(8)));
typedef GAS unsigned gu32;
typedef GAS unsigned long long gu64;
#define RLX_AGENT __ATOMIC_RELAXED, __HIP_MEMORY_SCOPE_AGENT
#define LDS_WAIT() asm volatile("s_waitcnt lgkmcnt(0)" ::: "memory")
#define VM_WAIT() asm volatile("s_waitcnt vmcnt(0)" ::: "memory")
__device__ __forceinline__ unsigned long long rt() { return __builtin_amdgcn_s_memrealtime(); }
__device__ __forceinline__ unsigned f2bf(float f) { unsigned u = __builtin_bit_cast(unsigned, f); return (u + 0x7fffu + ((u >> 16) & 1u)) >> 16; }
__device__ __forceinline__ unsigned pk2(float lo, float hi) { return f2bf(lo) | (f2bf(hi) << 16); }

#define XB_TMO      128
#define XB_XCNT(j)  (256  + 64 * (j))
#define XB_XSUB(j)  (1280 + 64 * (j))
#define XB_XGEN(j)  (2304 + 64 * (j))
#define XB_TOP      3328
#define XB_TOPGEN   3392
#define XCD_BAR_WORDS 3456
#define XB_SPIN_CAP (1u << 22)

__device__ __forceinline__ unsigned xb_ld(unsigned* p)              { return __hip_atomic_load(p, __ATOMIC_RELAXED, __HIP_MEMORY_SCOPE_AGENT); }
__device__ __forceinline__ unsigned xb_add(unsigned* p, unsigned v) { return __hip_atomic_fetch_add(p, v, __ATOMIC_RELAXED, __HIP_MEMORY_SCOPE_AGENT); }
__device__ __forceinline__ unsigned xb_xcc_id() { return (unsigned)__builtin_amdgcn_s_getreg((3 << 11) | 20) & 0xFu; }
#define XB_SPIN(cond, bar) do { unsigned _sp = 0; while (cond) { __builtin_amdgcn_s_sleep(1); \
    if ((++_sp & 255u) == 0u) { if (xb_ld(&(bar)[XB_TMO])) break; if (_sp > XB_SPIN_CAP) { atomicAdd(&(bar)[XB_TMO], 1u); break; } } } } while (0)

struct XcdBarrier {
    unsigned* bar; unsigned x;
    volatile LAS unsigned* st;
};

__device__ __forceinline__ XcdBarrier xcd_barrier_post(unsigned* bar, volatile LAS unsigned* st) {
    XcdBarrier b; b.bar = bar; b.x = xb_xcc_id(); b.st = st;
    if (threadIdx.x == 0) (void)xb_add(&bar[XB_XCNT(b.x)], 1u);
    return b;
}
__device__ __forceinline__ void xcd_barrier_complete(unsigned* bar, unsigned x, unsigned& nloc, unsigned& nx) {
    const unsigned G = gridDim.x * gridDim.y * gridDim.z;
    unsigned sum, cnt, mine, sp = 0u;
    for (;;) {
        sum = 0u; cnt = 0u; mine = 0u;
#pragma unroll
        for (unsigned j = 0; j < 16; ++j) { const unsigned c = xb_ld(&bar[XB_XCNT(j)]); sum += c; cnt += (c > 0u) ? 1u : 0u; mine = (j == x) ? c : mine; }
        if (sum == G) break;
        __builtin_amdgcn_s_sleep(1);
        if ((++sp & 255u) == 0u) { if (xb_ld(&bar[XB_TMO])) break; if (sp > XB_SPIN_CAP) { atomicAdd(&bar[XB_TMO], 1u); break; } }
    }
    nloc = mine > 0u ? mine : 1u; nx = cnt > 0u ? cnt : 1u;
}

__device__ __forceinline__ void xcd_barrier(const XcdBarrier& b) {
    asm volatile("s_waitcnt vmcnt(0)" ::: "memory");
    __syncthreads();
    if (threadIdx.x == 0) {
        unsigned* bar = b.bar;
        __builtin_amdgcn_s_waitcnt(0);
        unsigned nloc = b.st[0], nx = b.st[1];
        if (nloc == 0u) { xcd_barrier_complete(bar, b.x, nloc, nx); b.st[0] = nloc; b.st[1] = nx; }
        const unsigned old = xb_add(&bar[XB_XSUB(b.x)], 1u);
        const unsigned gen = old / nloc;
        if (old + 1u == (gen + 1u) * nloc) {
            __builtin_amdgcn_fence(__ATOMIC_RELEASE, "agent");
            asm volatile("s_waitcnt vmcnt(0)" ::: "memory");
            const unsigned og = xb_add(&bar[XB_TOP], 1u);
            const unsigned tg = og / nx;
            if (og + 1u == (tg + 1u) * nx) xb_add(&bar[XB_TOPGEN], 1u);
            else XB_SPIN(xb_ld(&bar[XB_TOPGEN]) == tg, bar);
            __builtin_amdgcn_fence(__ATOMIC_ACQUIRE, "agent");
            xb_add(&bar[XB_XGEN(b.x)], 1u);
            asm volatile("s_waitcnt vmcnt(0)" ::: "memory");
        } else {
            XB_SPIN(xb_ld(&bar[XB_XGEN(b.x)]) == gen, bar);
            __builtin_amdgcn_fence(__ATOMIC_ACQUIRE, "agent");
            asm volatile("s_waitcnt vmcnt(0)" ::: "memory");
        }
    }
    __syncthreads();
}


constexpr int NWAVES = 8;
constexpr int NB = 4, S = 8192, D = 1024, M = NB * S, FF = 4096;
constexpr int DIN = 2376, DINP = 2560;
constexpr int C_Q = 0, C_K = 512, C_V = 640, C_QI = 768, C_KI = 1280, C_WI = 1344, C_A = 1352, C_G = 1864;
constexpr int CONVK = 31, CCH = 512, MODW = 6 * D;
constexpr float EPS = 1e-6f;
constexpr float WI_SCALE = 0.04419417382415922f;
constexpr float SM_SCALE_LOG2E = 0.125f * 1.4426950408889634f;

constexpr size_t MiB = 1u << 20;
constexpr size_t WS_CTL = 0, CTL_ZERO_BYTES = 1 * MiB;
constexpr size_t WS_WIN = 1 * MiB, WS_WOUT = 6 * MiB, WS_WUP = 8 * MiB, WS_WDN = 16 * MiB;
constexpr size_t WS_MOD = 24 * MiB, WS_BIAS2 = 24 * MiB + 128 * 1024, WS_CS = 25 * MiB, WS_PART = 27 * MiB;
constexpr size_t WS_H = 32 * MiB;
constexpr size_t WS_PROJ = 96 * MiB;
constexpr size_t WS_Q = 256 * MiB, WS_K = 288 * MiB, WS_V = 296 * MiB, WS_QI = 304 * MiB, WS_KI = 336 * MiB, WS_WI = 340 * MiB, WS_GLU = 344 * MiB;
constexpr size_t WS_MIX = 376 * MiB;
constexpr size_t WS_U = 96 * MiB;
constexpr size_t WS_SEL = 440 * MiB;
constexpr size_t WS_NSEL = 456 * MiB;
constexpr size_t WS_END = 457 * MiB;
constexpr int CW_BAR = 4096;

constexpr int RING_OFF = 0, RING_BYTES = 131072;
constexpr int LDSCTL_OFF = 147456, MISC_OFF = LDSCTL_OFF + 320;
constexpr int LDS_BYTES = 148480;

struct Frame {
    LAS unsigned char* lds;
    volatile LAS unsigned* MISC;
    gu32* ctl;
    int tid, lane, wave;
    int vcu, G;
    const float *x, *c, *w_ada, *b_ada, *g_mix, *w_in, *conv_w, *conv_b, *conv_ng, *conv_nb, *w_out, *g_mlp, *w_up, *w_down, *g_final;
    const int* positions;
    float* out;
    bf16 *Win_t, *Wout_t, *Wup_t, *Wdn_t;
    float *mod, *CS, *WI, *BIAS2, *PART;
    bf16 *H, *PROJ, *Q, *K, *V, *QI, *KI, *GLU, *MIX, *U;
    unsigned short* SEL; int* NSEL;
};

__device__ __forceinline__ float wave_sum(float v) {
#pragma unroll
    for (int o = 1; o < 64; o <<= 1) v += __shfl_xor(v, o);
    return v;
}
__device__ __forceinline__ float bf2f(unsigned u16) { return __uint_as_float(u16 << 16); }

__device__ __forceinline__ int proj_src_col(int p) {
    if (p < C_A) return p;
    if (p < 6 * 256) return -1;
    const int t = (p >> 8) - 6, x = p & 255;
    return (x < 128) ? (C_A + 128 * t + x) : (C_G + 128 * t + (x - 128));
}
template <bool MAP>
__device__ __forceinline__ void p0_transpose_item(const float* W, int K, int N, int Npad, bf16* WT, LAS float* scr, int item, int lane) {
    const int nblk = Npad / 32, kb = item / nblk, nb = item % nblk, k0 = 64 * kb, n0 = 32 * nb;
    const int ncol = MAP ? proj_src_col(n0 + (lane & 31)) : (n0 + (lane & 31)); const bool ok = ncol >= 0 && ncol < N;
#pragma unroll 8
    for (int i = 0; i < 32; ++i) { const int kk = 2 * i + (lane >> 5); scr[kk * 33 + (lane & 31)] = ok ? W[(size_t)(k0 + kk) * N + ncol] : 0.f; }
    LDS_WAIT(); asm volatile("" ::: "memory");
    const int c = lane & 7;
#pragma unroll
    for (int j = 0; j < 4; ++j) { const int n = (lane >> 3) + 8 * j; const LAS float* s = scr + (8 * c) * 33 + n;
        v4u o; o.x = pk2(s[0 * 33], s[1 * 33]); o.y = pk2(s[2 * 33], s[3 * 33]); o.z = pk2(s[4 * 33], s[5 * 33]); o.w = pk2(s[6 * 33], s[7 * 33]);
        *(GAS v4u*)(WT + (size_t)(n0 + n) * K + k0 + 8 * c) = o; }
    LDS_WAIT(); asm volatile("" ::: "memory");
}

__device__ __forceinline__ void p0_prologue(Frame& F) {
    LAS float* cond = (LAS float*)(F.lds + 73728);
    for (int i = F.tid; i < NB * D; i += NWAVES * 64) { const float v = F.c[i]; cond[i] = v / (1.f + expf(-v)); }
    __syncthreads();
    const int gw = F.vcu * NWAVES + F.wave, NGW = F.G * NWAVES, lane = F.lane;
    for (int it = gw; it < MODW / 16; it += NGW) {
        const int col = it * 16 + (lane & 15), kg = lane >> 4;
        float a0 = 0.f, a1 = 0.f, a2 = 0.f, a3 = 0.f;
        const float* wp = F.w_ada + (size_t)kg * MODW + col;
#pragma unroll 16
        for (int i = 0; i < D / 4; ++i) { const int k = kg + 4 * i; const float w = wp[(size_t)i * 4 * MODW];
            a0 += w * cond[k]; a1 += w * cond[D + k]; a2 += w * cond[2 * D + k]; a3 += w * cond[3 * D + k]; }
        a0 += __shfl_xor(a0, 16); a0 += __shfl_xor(a0, 32); a1 += __shfl_xor(a1, 16); a1 += __shfl_xor(a1, 32);
        a2 += __shfl_xor(a2, 16); a2 += __shfl_xor(a2, 32); a3 += __shfl_xor(a3, 16); a3 += __shfl_xor(a3, 32);
        if (lane < 16) { const float bb = F.b_ada[col]; F.mod[col] = a0 + bb; F.mod[MODW + col] = a1 + bb; F.mod[2 * MODW + col] = a2 + bb; F.mod[3 * MODW + col] = a3 + bb; }
    }
    LAS float* scr = (LAS float*)(F.lds + F.wave * 8448);
    constexpr int I_IN = (D / 64) * (DINP / 32), I_OUT = (D / 64) * (D / 32), I_UP = (D / 64) * (FF / 32), I_DN = (FF / 64) * (D / 32);
    constexpr int NITEMS = I_IN + I_OUT + I_UP + I_DN;
    for (int it = gw; it < NITEMS; it += NGW) {
        int r = it;
        if (r < I_IN) { p0_transpose_item<true>(F.w_in, D, DIN, DINP, F.Win_t, scr, r, lane); continue; } r -= I_IN;
        if (r < I_OUT) { p0_transpose_item<false>(F.w_out, D, D, D, F.Wout_t, scr, r, lane); continue; } r -= I_OUT;
        if (r < I_UP) { p0_transpose_item<false>(F.w_up, D, FF, FF, F.Wup_t, scr, r, lane); continue; } r -= I_UP;
        p0_transpose_item<false>(F.w_down, FF, D, D, F.Wdn_t, scr, r, lane);
    }
    for (int i = gw * 64 + lane; i < M * 8; i += NGW * 64) {
        const int m = i >> 3, f = i & 7;
        const float invf = (f == 0) ? 1.0f : (f == 1) ? 0.1939227432012558f : (f == 2) ? 0.03760603070259094f : (f == 3) ? 0.007292664609849453f
                         : (f == 4) ? 0.0014142135623842478f : (f == 5) ? 0.00027424818836152554f : (f == 6) ? 5.3182957344688475e-05f : 1.0313385246263351e-05f;
        const float ang = (float)F.positions[m] * invf;
        const double a = (double)ang, q = rint(a * 0.63661977236758134308), rr = a - q * 1.57079632679489661923, r2 = rr * rr;
        const int n = (int)q;
        const double sn = rr * (1.0 + r2 * (-1.0 / 6 + r2 * (1.0 / 120 + r2 * (-1.0 / 5040 + r2 * (1.0 / 362880 + r2 * (-1.0 / 39916800 + r2 * (1.0 / 6227020800.0)))))));
        const double cs = 1.0 + r2 * (-0.5 + r2 * (1.0 / 24 + r2 * (-1.0 / 720 + r2 * (1.0 / 40320 + r2 * (-1.0 / 3628800 + r2 * (1.0 / 479001600 + r2 * (-1.0 / 87178291200.0)))))));
        double so, co;
        switch (n & 3) { case 0: so = sn; co = cs; break; case 1: so = cs; co = -sn; break; case 2: so = -sn; co = -cs; break; default: so = -cs; co = sn; break; }
        F.CS[(size_t)m * 16 + f] = (float)co; F.CS[(size_t)m * 16 + 8 + f] = (float)so;
    }
}

__device__ __forceinline__ void bias2_gemv(Frame& F, const float* sh2) {
    const int gw = F.vcu * NWAVES + F.wave, NGW = F.G * NWAVES, lane = F.lane;
    f32x4 sh[4][4];
#pragma unroll
    for (int b = 0; b < 4; ++b)
#pragma unroll
        for (int j = 0; j < 4; ++j) sh[b][j] = *(const f32x4*)(sh2 + (size_t)b * MODW + 16 * lane + 4 * j);
    for (int n = gw; n < FF; n += NGW) {
        const v4u w0 = *(const v4u*)(F.Wup_t + (size_t)n * D + 16 * lane), w1 = *(const v4u*)(F.Wup_t + (size_t)n * D + 16 * lane + 8);
        const f32x4 x0 = (f32x4){bf2f(w0.x & 0xffffu), bf2f(w0.x >> 16), bf2f(w0.y & 0xffffu), bf2f(w0.y >> 16)}, x1 = (f32x4){bf2f(w0.z & 0xffffu), bf2f(w0.z >> 16), bf2f(w0.w & 0xffffu), bf2f(w0.w >> 16)};
        const f32x4 x2 = (f32x4){bf2f(w1.x & 0xffffu), bf2f(w1.x >> 16), bf2f(w1.y & 0xffffu), bf2f(w1.y >> 16)}, x3 = (f32x4){bf2f(w1.z & 0xffffu), bf2f(w1.z >> 16), bf2f(w1.w & 0xffffu), bf2f(w1.w >> 16)};
#pragma unroll
        for (int b = 0; b < 4; ++b) { const f32x4 t = sh[b][0] * x0 + sh[b][1] * x1 + sh[b][2] * x2 + sh[b][3] * x3;
            const float s = wave_sum((t[0] + t[1]) + (t[2] + t[3])); if (lane == 0) F.BIAS2[(size_t)b * FF + n] = s; }
    }
}
__device__ __forceinline__ void normmod_rows(Frame& F, const float* X, const float* g, const float* sh, const float* sc, bf16* out) {
    const int gw = F.vcu * NWAVES + F.wave, NGW = F.G * NWAVES, lane = F.lane;
    for (int blk = gw; blk < M / 16; blk += NGW) {
        const int r0 = blk * 16, b = r0 / S;
        f32x4 A[4], Bv[4];
#pragma unroll
        for (int j = 0; j < 4; ++j) { const int c = 4 * lane + 256 * j; const f32x4 gg = *(const f32x4*)(g + c), s1 = *(const f32x4*)(sc + (size_t)b * MODW + c);
            A[j] = gg * (s1 + 1.0f); Bv[j] = *(const f32x4*)(sh + (size_t)b * MODW + c); }
        for (int r = 0; r < 16; ++r) {
            const GAS f32x4* xr = (const GAS f32x4*)(X + (size_t)(r0 + r) * D) + lane;
            f32x4 v[4]; float ss = 0.f;
#pragma unroll
            for (int j = 0; j < 4; ++j) { v[j] = xr[64 * j]; ss += (v[j].x * v[j].x + v[j].y * v[j].y) + (v[j].z * v[j].z + v[j].w * v[j].w); }
            const float rinv = 1.0f / sqrtf(wave_sum(ss) * (1.0f / D) + EPS);
            GAS unsigned long long* o8 = (GAS unsigned long long*)(out + (size_t)(r0 + r) * D) + lane;
#pragma unroll
            for (int j = 0; j < 4; ++j) { const f32x4 y = v[j] * rinv * A[j] + Bv[j];
                o8[64 * j] = (unsigned long long)pk2(y.x, y.y) | ((unsigned long long)pk2(y.z, y.w) << 32); }
        }
    }
}
__device__ __forceinline__ void final_norm_rows(Frame& F, float* X, const float* g) {
    const int gw = F.vcu * NWAVES + F.wave, NGW = F.G * NWAVES, lane = F.lane;
    f32x4 A[4];
#pragma unroll
    for (int j = 0; j < 4; ++j) A[j] = *(const f32x4*)(g + 4 * lane + 256 * j);
    for (int blk = gw; blk < M / 16; blk += NGW) {
        for (int r = 0; r < 16; ++r) {
            GAS f32x4* xr = (GAS f32x4*)(X + (size_t)(blk * 16 + r) * D) + lane;
            f32x4 v[4]; float ss = 0.f;
#pragma unroll
            for (int j = 0; j < 4; ++j) { v[j] = xr[64 * j]; ss += (v[j].x * v[j].x + v[j].y * v[j].y) + (v[j].z * v[j].z + v[j].w * v[j].w); }
            const float rinv = 1.0f / sqrtf(wave_sum(ss) * (1.0f / D) + EPS);
#pragma unroll
            for (int j = 0; j < 4; ++j) xr[64 * j] = v[j] * rinv * A[j];
        }
    }
}

__device__ __forceinline__ void p3_post(Frame& F) {
    const int gw = F.vcu * NWAVES + F.wave, NGW = F.G * NWAVES, lane = F.lane;
    const int l31 = lane & 31; const bool rot = l31 < 8, isx1 = l31 < 4; const int i0 = 2 * (lane & 3);
    for (int blk = gw; blk < M / 16; blk += NGW) {
        for (int r = 0; r < 16; ++r) {
            const size_t m = (size_t)blk * 16 + r;
            const bf16* pr = F.PROJ + m * DINP;
            const float c0 = F.CS[m * 16 + i0], c1 = F.CS[m * 16 + i0 + 1], s0 = F.CS[m * 16 + 8 + i0], s1 = F.CS[m * 16 + 8 + i0 + 1];
#pragma unroll
            for (int j = 0; j < 11; ++j) {
                const unsigned u = *(const unsigned*)(pr + 128 * j + 2 * lane);
                float v0 = bf2f(u & 0xffffu), v1 = bf2f(u >> 16);
                if (j != 5) {
                    const float p0 = __shfl_xor(v0, 4), p1 = __shfl_xor(v1, 4);
                    if (rot && !(j == 10 && lane >= 32)) {
                        if (isx1) { v0 = v0 * c0 - p0 * s0; v1 = v1 * c1 - p1 * s1; } else { v0 = v0 * c0 + p0 * s0; v1 = v1 * c1 + p1 * s1; }
                    }
                }
                const unsigned w = pk2(v0, v1);
                if (j < 4) *(unsigned*)(F.Q + m * 512 + 128 * j + 2 * lane) = w;
                else if (j == 4) *(unsigned*)(F.K + m * 128 + 2 * lane) = w;
                else if (j == 5) *(unsigned*)(F.V + m * 128 + 2 * lane) = w;
                else if (j < 10) *(unsigned*)(F.QI + m * 512 + 128 * (j - 6) + 2 * lane) = w;
                else { if (lane < 32) *(unsigned*)(F.KI + m * 64 + 2 * lane) = w;
                       else if (lane < 36) { F.WI[m * 8 + 2 * (lane - 32)] = v0 * WI_SCALE; F.WI[m * 8 + 2 * (lane - 32) + 1] = v1 * WI_SCALE; } }
            }
#pragma unroll
            for (int j = 0; j < 4; ++j) {
                const int ch = 128 * j + 2 * lane;
                const unsigned ua = *(const unsigned*)(pr + C_A + ch), ug = *(const unsigned*)(pr + C_G + ch);
                const float a0 = bf2f(ua & 0xffffu), a1 = bf2f(ua >> 16), g0 = bf2f(ug & 0xffffu), g1 = bf2f(ug >> 16);
                *(unsigned*)(F.GLU + m * CCH + ch) = pk2(a0 / (1.f + __expf(-g0)), a1 / (1.f + __expf(-g1)));
            }
        }
    }
}

__device__ __forceinline__ void p4_conv(Frame& F) {
    LAS f32x4* wl = (LAS f32x4*)(F.lds);
    LAS unsigned char* inl = F.lds + 63488;
    const int lane = F.lane;
    for (int i = F.tid; i < CONVK * CCH; i += NWAVES * 64) { const int j = i / CCH, ch = i % CCH;
        ((LAS float*)wl)[((j * 2 + ((ch >> 2) & 1)) * 64 + (ch >> 3)) * 4 + (ch & 3)] = F.conv_w[i]; }
    f32x4 cb[2], ng[2], nb[2];
#pragma unroll
    for (int h = 0; h < 2; ++h) { cb[h] = *(const f32x4*)(F.conv_b + 8 * lane + 4 * h); ng[h] = *(const f32x4*)(F.conv_ng + 8 * lane + 4 * h); nb[h] = *(const f32x4*)(F.conv_nb + 8 * lane + 4 * h); }
    for (int tile = F.vcu; tile < M / 32; tile += F.G) {
        __syncthreads();
        const int m0 = tile * 32, s0 = m0 & (S - 1);
        for (int i = F.tid; i < 62 * 64; i += NWAVES * 64) { const int r = i >> 6, cc = i & 63;
            v4u v = (v4u){0u, 0u, 0u, 0u};
            if (s0 - 30 + r >= 0) v = *(const v4u*)(F.GLU + (size_t)(m0 - 30 + r) * CCH + cc * 8);
            *(LAS v4u*)(inl + r * 1024 + cc * 16) = v; }
        __syncthreads();
        for (int tt = 0; tt < 4; ++tt) {
            const int tl = F.wave * 4 + tt;
            f32x4 a0 = cb[0], a1 = cb[1];
#pragma unroll 2
            for (int j = 0; j < CONVK; ++j) {
                const v4u in = *(const LAS v4u*)(inl + (tl + j) * 1024 + lane * 16);
                const f32x4 w0 = wl[(j * 2 + 0) * 64 + lane], w1 = wl[(j * 2 + 1) * 64 + lane];
                const f32x4 x0 = (f32x4){bf2f(in.x & 0xffffu), bf2f(in.x >> 16), bf2f(in.y & 0xffffu), bf2f(in.y >> 16)};
                const f32x4 x1 = (f32x4){bf2f(in.z & 0xffffu), bf2f(in.z >> 16), bf2f(in.w & 0xffffu), bf2f(in.w >> 16)};
                a0 += w0 * x0; a1 += w1 * x1;
            }
            const float mean = wave_sum((a0.x + a0.y) + (a0.z + a0.w) + (a1.x + a1.y) + (a1.z + a1.w)) * (1.0f / CCH);
            a0 = a0 - mean; a1 = a1 - mean;
            const float var = wave_sum((a0.x * a0.x + a0.y * a0.y) + (a0.z * a0.z + a0.w * a0.w) + (a1.x * a1.x + a1.y * a1.y) + (a1.z * a1.z + a1.w * a1.w)) * (1.0f / CCH);
            const float rstd = 1.0f / sqrtf(var + EPS);
            f32x4 y0 = a0 * rstd * ng[0] + nb[0], y1 = a1 * rstd * ng[1] + nb[1];
            y0 = (f32x4){y0.x / (1.f + __expf(-y0.x)), y0.y / (1.f + __expf(-y0.y)), y0.z / (1.f + __expf(-y0.z)), y0.w / (1.f + __expf(-y0.w))};
            y1 = (f32x4){y1.x / (1.f + __expf(-y1.x)), y1.y / (1.f + __expf(-y1.y)), y1.z / (1.f + __expf(-y1.z)), y1.w / (1.f + __expf(-y1.w))};
            v4u o; o.x = pk2(y0.x, y0.y); o.y = pk2(y0.z, y0.w); o.z = pk2(y1.x, y1.y); o.w = pk2(y1.z, y1.w);
            *(GAS v4u*)(F.MIX + (size_t)(m0 + tl) * D + CCH + 8 * lane) = o;
        }
    }
    __syncthreads();
}

constexpr int DC = 768, DNR = DC / 64, TOPK = 256, DSLACK = 64;
constexpr int DSA_RING = 0, DSA_SLOT = 16384, DSA_CAND = 3 * DSA_SLOT;
static_assert(DSA_CAND + 32 * DC * 4 <= LDSCTL_OFF, "DSA LDS map");
typedef float f32x16 __attribute__((ext_vector_type(16)));
typedef float f32x2 __attribute__((ext_vector_type(2)));
__device__ __forceinline__ unsigned ordkey(float s, int key) {
    unsigned u = __float_as_uint(s); u ^= (unsigned)((int)u >> 31) | 0x80000000u;
    return (u & 0xFFFFE000u) | (unsigned)(8191 - key);
}
__device__ __forceinline__ int mbcnt64(unsigned long long mk) { return (int)__builtin_amdgcn_mbcnt_hi((unsigned)(mk >> 32), __builtin_amdgcn_mbcnt_lo((unsigned)mk, 0u)); }
constexpr int DKL = 24;
template <int SLACK, bool ALL>
__device__ __forceinline__ int dsa_cut(LAS unsigned* buf, int lane, unsigned& tau) {
    unsigned e[DNR]; unsigned mxl = 0u;
#pragma unroll
    for (int i = 0; i < DNR; ++i) { e[i] = buf[i * 64 + lane]; mxl = mxl > e[i] ? mxl : e[i]; }
    unsigned thr = 1u;
    if (!ALL) {
#pragma unroll
        for (int o = 1; o < 64; o <<= 1) { const unsigned other = (unsigned)__shfl_xor((int)mxl, o); mxl = mxl > other ? mxl : other; }
        unsigned lo = tau, hi = (unsigned)__builtin_amdgcn_readfirstlane((int)mxl) + 1u;
#pragma unroll 1
        for (;;) {
            const unsigned mid = lo + ((hi - lo) >> 1); int c = 0;
#pragma unroll
            for (int i = 0; i < DNR; ++i) c += __popcll(__ballot(e[i] >= mid));
            if (c < TOPK) hi = mid; else if (c > TOPK + SLACK) lo = mid; else { thr = mid; break; }
        }
        tau = thr;
    }
    int base = 0;
#pragma unroll
    for (int i = 0; i < DNR; ++i) { const bool k = e[i] >= thr; const unsigned long long mk = __ballot(k); const int pos = base + mbcnt64(mk); if (k) buf[pos] = e[i]; base += __popcll(mk); }
#pragma unroll
    for (int i = 0; i < DNR; ++i) { if (i * 64 + lane >= base) buf[i * 64 + lane] = 0u; }
    return base;
}

__device__ __forceinline__ void dsa_unit(Frame& F, int lane, int wave, int b, int qb) {
    const int r = lane & 31, hi = lane >> 5;
    const size_t mb = (size_t)b * S;
    const int t0 = 32 * qb + 4 * wave;
    LAS unsigned* cw = (LAS unsigned*)(F.lds + DSA_CAND) + wave * 4 * DC;
    const int a_ = r >> 2, i_ = r & 3, ql = ((a_ >> 2) & 1) + 2 * (a_ & 1), hd = 4 * ((a_ >> 1) & 1) + i_;
    const bf16* qip = F.QI + (mb + t0 + ql) * 512 + hd * 64 + hi * 8;
    bf16x8 A[4];
#pragma unroll
    for (int ks = 0; ks < 4; ++ks) A[ks] = *(const bf16x8*)(qip + ks * 16);
    f32x2 wv[8];
    { const f32x2* wp = (const f32x2*)(F.WI + (mb + t0 + 2 * hi) * 8);
#pragma unroll
      for (int q2 = 0; q2 < 8; ++q2) wv[q2] = wp[q2]; }
    const int tA = t0 + 2 * hi, tB = tA + 1;
    unsigned tau0 = 0u, tau1 = 0u, tau2 = 0u, tau3 = 0u;
    int cv0 = 0, cv1 = 0;
    LAS unsigned* const ap0 = cw + (2 * hi) * DC + r, * const ap1 = cw + (2 * hi + 1) * DC + r;
#define DSA_HALFSUM(v) do { v += __shfl_xor(v, 1); v += __shfl_xor(v, 2); v += __shfl_xor(v, 4); v += __shfl_xor(v, 8); v += __shfl_xor(v, 16); } while (0)
#define DSA_CUTALL(SL) do { int s0_ = cv0, s1_ = cv1; DSA_HALFSUM(s0_); DSA_HALFSUM(s1_); \
        const int n0_ = __builtin_amdgcn_readlane(s0_, 0), n2_ = __builtin_amdgcn_readlane(s0_, 32), n1_ = __builtin_amdgcn_readlane(s1_, 0), n3_ = __builtin_amdgcn_readlane(s1_, 32); \
        { const int c_ = (n0_ > TOPK + (SL)) ? dsa_cut<(SL), false>(cw + 0 * DC, lane, tau0) : dsa_cut<0, true>(cw + 0 * DC, lane, tau0); if (!hi) cv0 = (c_ + 31 - r) >> 5; } \
        { const int c_ = (n1_ > TOPK + (SL)) ? dsa_cut<(SL), false>(cw + 1 * DC, lane, tau1) : dsa_cut<0, true>(cw + 1 * DC, lane, tau1); if (!hi) cv1 = (c_ + 31 - r) >> 5; } \
        { const int c_ = (n2_ > TOPK + (SL)) ? dsa_cut<(SL), false>(cw + 2 * DC, lane, tau2) : dsa_cut<0, true>(cw + 2 * DC, lane, tau2); if (hi) cv0 = (c_ + 31 - r) >> 5; } \
        { const int c_ = (n3_ > TOPK + (SL)) ? dsa_cut<(SL), false>(cw + 3 * DC, lane, tau3) : dsa_cut<0, true>(cw + 3 * DC, lane, tau3); if (hi) cv1 = (c_ + 31 - r) >> 5; } } while (0)
#pragma unroll
    for (int i = 0; i < 4 * DNR; ++i) cw[i * 64 + lane] = 0u;
    const int nst = (qb >> 2) + 1;
    const int drow = 16 * wave + (lane >> 3), dch = (lane & 7) ^ ((drow >> 1) & 7);
    const int dch1 = (lane & 7) ^ (((drow + 8) >> 1) & 7);
    const bf16* dsrc0 = F.KI + (mb + drow) * 64 + dch * 8;
    const bf16* dsrc1 = F.KI + (mb + drow + 8) * 64 + dch1 * 8;
    LAS unsigned char* ring = F.lds + DSA_RING;
    int boff[4];
#pragma unroll
    for (int ks = 0; ks < 4; ++ks) boff[ks] = r * 128 + (((2 * ks + hi) ^ ((r >> 1) & 7)) << 4);
    volatile LAS unsigned* vote = F.MISC + 16;
#define DSA_DMA(stage, slot) do { __builtin_amdgcn_global_load_lds((const unsigned*)(dsrc0 + (size_t)(stage) * 128 * 64), (LAS unsigned*)(ring + (slot) * DSA_SLOT + wave * 2048), 16, 0, 0); \
        __builtin_amdgcn_global_load_lds((const unsigned*)(dsrc1 + (size_t)(stage) * 128 * 64), (LAS unsigned*)(ring + (slot) * DSA_SLOT + wave * 2048 + 1024), 16, 0, 0); } while (0)
    asm volatile("s_waitcnt lgkmcnt(0)" ::: "memory"); __builtin_amdgcn_s_barrier(); asm volatile("" ::: "memory");
    if (wave == 0 && lane < 3) vote[lane] = 0u;
    DSA_DMA(0, 0); DSA_DMA(nst > 1 ? 1 : 0, 1);
    int sl = 0;
#pragma unroll 1
    for (int st = 0; st < nst; ++st) {
        asm volatile("s_waitcnt vmcnt(2) lgkmcnt(0)" ::: "memory"); __builtin_amdgcn_s_barrier(); asm volatile("" ::: "memory");
        const int sl2 = (sl >= 1) ? sl - 1 : 2;
        DSA_DMA(st + 2 < nst ? st + 2 : nst - 1, sl2);
        const int vprev = (sl >= 1) ? sl - 1 : 2, vnext = (sl == 2) ? 0 : sl + 1;
        if (st > 0 && vote[vprev] != 0u) { DSA_CUTALL(DSLACK); }
        if (wave == 0 && lane == 0) vote[vnext] = 0u;
        const LAS unsigned char* sbase = ring + sl * DSA_SLOT;
        float scA[4], scB[4];
        bf16x8 Bf[16];
#pragma unroll
        for (int sub = 0; sub < 4; ++sub)
#pragma unroll
            for (int ks = 0; ks < 4; ++ks) Bf[sub * 4 + ks] = *(const LAS bf16x8*)(sbase + sub * 4096 + boff[ks]);
        __builtin_amdgcn_sched_barrier(0);
#pragma unroll
        for (int sub = 0; sub < 4; ++sub) {
            f32x16 acc = {0.f, 0.f, 0.f, 0.f, 0.f, 0.f, 0.f, 0.f, 0.f, 0.f, 0.f, 0.f, 0.f, 0.f, 0.f, 0.f};
            acc = __builtin_amdgcn_mfma_f32_32x32x16_bf16(A[0], Bf[sub * 4 + 0], acc, 0, 0, 0); acc = __builtin_amdgcn_mfma_f32_32x32x16_bf16(A[1], Bf[sub * 4 + 1], acc, 0, 0, 0);
            acc = __builtin_amdgcn_mfma_f32_32x32x16_bf16(A[2], Bf[sub * 4 + 2], acc, 0, 0, 0); acc = __builtin_amdgcn_mfma_f32_32x32x16_bf16(A[3], Bf[sub * 4 + 3], acc, 0, 0, 0);
            f32x2 sa = wv[0] * (f32x2){fmaxf(acc[0], 0.f), fmaxf(acc[1], 0.f)}, sa2 = wv[1] * (f32x2){fmaxf(acc[2], 0.f), fmaxf(acc[3], 0.f)};
            sa += wv[2] * (f32x2){fmaxf(acc[4], 0.f), fmaxf(acc[5], 0.f)}; sa2 += wv[3] * (f32x2){fmaxf(acc[6], 0.f), fmaxf(acc[7], 0.f)};
            f32x2 sb_ = wv[4] * (f32x2){fmaxf(acc[8], 0.f), fmaxf(acc[9], 0.f)}, sb2 = wv[5] * (f32x2){fmaxf(acc[10], 0.f), fmaxf(acc[11], 0.f)};
            sb_ += wv[6] * (f32x2){fmaxf(acc[12], 0.f), fmaxf(acc[13], 0.f)}; sb2 += wv[7] * (f32x2){fmaxf(acc[14], 0.f), fmaxf(acc[15], 0.f)};
            sa += sa2; sb_ += sb2;
            scA[sub] = sa.x + sa.y; scB[sub] = sb_.x + sb_.y;
        }
        const unsigned tauA = hi ? tau2 : tau0, tauB = hi ? tau3 : tau1;
#pragma unroll
        for (int sub = 0; sub < 4; ++sub) {
            const int key = st * 128 + sub * 32 + r;
            const unsigned pk0 = ordkey(scA[sub], key), pk1 = ordkey(scB[sub], key);
            const bool p0 = (key <= tA) && (pk0 > tauA), p1 = (key <= tB) && (pk1 > tauB);
            if (p0) { ap0[32 * cv0] = pk0; ++cv0; }
            if (p1) { ap1[32 * cv1] = pk1; ++cv1; }
        }
        { const int cm = cv0 > cv1 ? cv0 : cv1;
          if (__any(cm > DKL - 4) && lane == 0) vote[sl] = 1u; }
        sl = (sl == 2) ? 0 : sl + 1;
    }
    asm volatile("s_waitcnt vmcnt(0)" ::: "memory");
#undef DSA_DMA
    int cnt0, cnt1, cnt2, cnt3;
    { int s0_ = cv0, s1_ = cv1; DSA_HALFSUM(s0_); DSA_HALFSUM(s1_);
      const int n0_ = __builtin_amdgcn_readlane(s0_, 0), n2_ = __builtin_amdgcn_readlane(s0_, 32), n1_ = __builtin_amdgcn_readlane(s1_, 0), n3_ = __builtin_amdgcn_readlane(s1_, 32);
      cnt0 = (n0_ > TOPK) ? dsa_cut<0, false>(cw + 0 * DC, lane, tau0) : dsa_cut<0, true>(cw + 0 * DC, lane, tau0);
      cnt1 = (n1_ > TOPK) ? dsa_cut<0, false>(cw + 1 * DC, lane, tau1) : dsa_cut<0, true>(cw + 1 * DC, lane, tau1);
      cnt2 = (n2_ > TOPK) ? dsa_cut<0, false>(cw + 2 * DC, lane, tau2) : dsa_cut<0, true>(cw + 2 * DC, lane, tau2);
      cnt3 = (n3_ > TOPK) ? dsa_cut<0, false>(cw + 3 * DC, lane, tau3) : dsa_cut<0, true>(cw + 3 * DC, lane, tau3); }
#undef DSA_CUTALL
#undef DSA_HALFSUM
#pragma unroll
    for (int q = 0; q < 4; ++q) {
        const int nsel = (q == 0) ? cnt0 : (q == 1) ? cnt1 : (q == 2) ? cnt2 : cnt3;
        const LAS unsigned* sel = cw + q * DC;
        unsigned* dst = (unsigned*)(F.SEL + (mb + t0 + q) * 256);
#pragma unroll
        for (int j = 0; j < 2; ++j) { const int n = 128 * j + 2 * lane;
            const unsigned e0 = sel[n], e1 = sel[n + 1];
            const unsigned i0 = (n < nsel) ? (8191u - (e0 & 0x1FFFu)) : 0xFFFFu, i1 = (n + 1 < nsel) ? (8191u - (e1 & 0x1FFFu)) : 0xFFFFu;
            dst[64 * j + lane] = i0 | (i1 << 16); }
        if (lane == 0) F.NSEL[mb + t0 + q] = nsel;
    }
}

constexpr int ATT_SLOT = 4096, ATT_RING = 4 * ATT_SLOT, ATT_SELB = 512;
__device__ __forceinline__ void att_wave(Frame& F, int lane, int wave, int q0  ) {
    const int fr = lane & 15, fq = lane >> 4, g4 = fq, ch = fr, kh = ch >> 3;
    LAS unsigned char* ring = F.lds + wave * ATT_RING;
    LAS unsigned char* pbuf = ring + 3 * ATT_SLOT;
    LAS unsigned char* selb = F.lds + 8 * ATT_RING + wave * (2 * ATT_SELB);
    const size_t mb = (size_t)(q0 / S) * S;
    const unsigned char* Kb = (const unsigned char*)(F.K + mb * 128);
    const unsigned char* Vb = (const unsigned char*)(F.V + mb * 128);
    const int drow = lane >> 4, dpos = lane & 15;
    int koff[4];
#pragma unroll
    for (int ks = 0; ks < 4; ++ks) koff[ks] = fr * 256 + (((4 * ks + fq) ^ fr) << 4);
    const int voff = (4 * g4) * 256 + ch * 16;
    if (lane < 32) *(LAS v4u*)(selb + lane * 16) = *(const v4u*)(F.SEL + (size_t)q0 * 256 + lane * 8);
    int cur = 0;
#pragma unroll 1
    for (int qi = 0; qi < 16; ++qi) {
        const int m = q0 + qi;
        const LAS unsigned short* sl = (const LAS unsigned short*)(selb + cur * ATT_SELB);
        bf16x8 Bq[4];
#pragma unroll
        for (int ks = 0; ks < 4; ++ks) { const bool ok = (fr < 8) && ((fr >> 2) == (ks >> 1));
            bf16x8 v = {0, 0, 0, 0, 0, 0, 0, 0};
            if (ok) v = *(const bf16x8*)(F.Q + (size_t)m * 512 + fr * 64 + (ks & 1) * 32 + fq * 8);
            Bq[ks] = v; }
        const int nselq = F.NSEL[m];
        v4u nsl = (v4u){0u, 0u, 0u, 0u};
        if (qi < 15 && lane < 32) nsl = *(const v4u*)(F.SEL + (size_t)(m + 1) * 256 + lane * 8);
        asm volatile("s_waitcnt lgkmcnt(0)" ::: "memory");
#define ATT_DMA(isv, c_, slot_) do { const unsigned char* tb_ = (isv) ? Vb : Kb; \
            _Pragma("unroll") for (int k_ = 0; k_ < 4; ++k_) { const int row_ = 4 * k_ + drow; unsigned sx_ = sl[16 * (c_) + row_]; sx_ = (sx_ == 0xFFFFu) ? 0u : sx_; \
                const int piece_ = (isv) ? dpos : (dpos ^ row_); \
                __builtin_amdgcn_global_load_lds((const unsigned*)(tb_ + (size_t)sx_ * 256 + piece_ * 16), (LAS unsigned*)(ring + (slot_) * ATT_SLOT + k_ * 1024), 16, 0, 0); } } while (0)
#define ATT_WAIT(n) asm volatile("s_waitcnt vmcnt(" #n ")" ::: "memory")
        ATT_DMA(false, 0, 0); ATT_DMA(false, 1, 1);
        f32x4 lg[16];
#pragma unroll
        for (int c = 0; c < 16; ++c) {
            ATT_WAIT(4);
            if (c + 2 < 16) ATT_DMA(false, c + 2, (c + 2) % 3); else ATT_DMA(true, c + 2 - 16, (c + 2) % 3);
            const LAS unsigned char* sb = ring + (c % 3) * ATT_SLOT;
            f32x4 a4 = {0.f, 0.f, 0.f, 0.f};
#pragma unroll
            for (int ks = 0; ks < 4; ++ks) a4 = __builtin_amdgcn_mfma_f32_16x16x32_bf16(*(const LAS bf16x8*)(sb + koff[ks]), Bq[ks], a4, 0, 0, 0);
            lg[c] = a4;
            asm volatile("s_waitcnt lgkmcnt(0)" ::: "memory");
        }
        float mx = -INFINITY; const int nsq = nselq - 4 * fq;
#pragma unroll
        for (int c = 0; c < 16; ++c)
#pragma unroll
            for (int g = 0; g < 4; ++g) { const float xv = (16 * c + g < nsq) ? lg[c][g] * SM_SCALE_LOG2E : -INFINITY; lg[c][g] = xv; mx = fmaxf(mx, xv); }
        mx = fmaxf(mx, __shfl_xor(mx, 16)); mx = fmaxf(mx, __shfl_xor(mx, 32));
        float sm = 0.f;
#pragma unroll
        for (int c = 0; c < 16; ++c)
#pragma unroll
            for (int g = 0; g < 4; ++g) { const float p = __builtin_amdgcn_exp2f(lg[c][g] - mx); lg[c][g] = p; sm += p; }
        sm += __shfl_xor(sm, 16); sm += __shfl_xor(sm, 32);
        const float inv = 1.0f / sm;
        if (fr < 8) {
            LAS unsigned short* pw = (LAS unsigned short*)(pbuf + (4 * fq) * 16 + 2 * fr);
#pragma unroll
            for (int c = 0; c < 16; ++c)
#pragma unroll
                for (int g = 0; g < 4; ++g) pw[(16 * c + g) * 8] = (unsigned short)f2bf(lg[c][g] * inv);
        }
        asm volatile("s_waitcnt lgkmcnt(0)" ::: "memory");
        f32x2 oa[4][4];
#pragma unroll
        for (int h = 0; h < 4; ++h)
#pragma unroll
            for (int dp = 0; dp < 4; ++dp) oa[h][dp] = (f32x2){0.f, 0.f};
        int slv = 16 % 3;
#pragma unroll 1
        for (int c = 0; c < 16; ++c) {
            if (c < 15) ATT_WAIT(4); else ATT_WAIT(0);
            { const int s2 = (slv >= 1) ? slv - 1 : 2;
              if (c + 2 < 16) ATT_DMA(true, c + 2, s2); }
            if (c == 14) { if (qi < 15 && lane < 32) *(LAS v4u*)(selb + (cur ^ 1) * ATT_SELB + lane * 16) = nsl; }
            const LAS unsigned char* sb = ring + slv * ATT_SLOT + voff;
            const LAS unsigned char* pp = pbuf + (16 * c + 4 * g4) * 16 + kh * 8;
#pragma unroll
            for (int i = 0; i < 4; ++i) {
                const v4u vv = *(const LAS v4u*)(sb + i * 256);
                const unsigned long long pq = *(const LAS unsigned long long*)(pp + i * 16);
                const unsigned plo = (unsigned)pq, phi = (unsigned)(pq >> 32);
                const float ph0 = bf2f(plo & 0xffffu), ph1 = __uint_as_float(plo & 0xffff0000u), ph2 = bf2f(phi & 0xffffu), ph3 = __uint_as_float(phi & 0xffff0000u);
                const f32x2 x0 = (f32x2){bf2f(vv.x & 0xffffu), __uint_as_float(vv.x & 0xffff0000u)}, x1 = (f32x2){bf2f(vv.y & 0xffffu), __uint_as_float(vv.y & 0xffff0000u)};
                const f32x2 x2 = (f32x2){bf2f(vv.z & 0xffffu), __uint_as_float(vv.z & 0xffff0000u)}, x3 = (f32x2){bf2f(vv.w & 0xffffu), __uint_as_float(vv.w & 0xffff0000u)};
                { const f32x2 p2 = (f32x2){ph0, ph0}; oa[0][0] += p2 * x0; oa[0][1] += p2 * x1; oa[0][2] += p2 * x2; oa[0][3] += p2 * x3; }
                { const f32x2 p2 = (f32x2){ph1, ph1}; oa[1][0] += p2 * x0; oa[1][1] += p2 * x1; oa[1][2] += p2 * x2; oa[1][3] += p2 * x3; }
                { const f32x2 p2 = (f32x2){ph2, ph2}; oa[2][0] += p2 * x0; oa[2][1] += p2 * x1; oa[2][2] += p2 * x2; oa[2][3] += p2 * x3; }
                { const f32x2 p2 = (f32x2){ph3, ph3}; oa[3][0] += p2 * x0; oa[3][1] += p2 * x1; oa[3][2] += p2 * x2; oa[3][3] += p2 * x3; }
            }
            asm volatile("s_waitcnt lgkmcnt(0)" ::: "memory");
            slv = (slv == 2) ? 0 : slv + 1;
        }
#undef ATT_DMA
#undef ATT_WAIT
#pragma unroll
        for (int h = 0; h < 4; ++h)
#pragma unroll
            for (int dp = 0; dp < 4; ++dp) { float a = oa[h][dp].x, c2 = oa[h][dp].y; a += __shfl_xor(a, 16); a += __shfl_xor(a, 32); c2 += __shfl_xor(c2, 16); c2 += __shfl_xor(c2, 32); oa[h][dp] = (f32x2){a, c2}; }
        if (lane < 16) {
            bf16* op = F.MIX + (size_t)m * D + (kh * 4) * 64 + 8 * (ch & 7);
#pragma unroll
            for (int h = 0; h < 4; ++h) { v4u o; o.x = pk2(oa[h][0].x, oa[h][0].y); o.y = pk2(oa[h][1].x, oa[h][1].y); o.z = pk2(oa[h][2].x, oa[h][2].y); o.w = pk2(oa[h][3].x, oa[h][3].y);
                *(v4u*)(op + h * 64) = o; }
        }
        asm volatile("s_waitcnt vmcnt(0)" ::: "memory");
        cur ^= 1;
    }
}
__device__ __forceinline__ void p4_att(Frame& F) {
    int lane = threadIdx.x & 63; asm volatile("" : "+v"(lane));
    const int gw = F.vcu * NWAVES + F.wave, NGW = F.G * NWAVES;
    for (int w = gw; w < M / 16; w += NGW) att_wave(F, lane, F.wave, 16 * w);
    __syncthreads();
}

__device__ __forceinline__ void p4_dsa(Frame& F) {
    int lane = threadIdx.x & 63; asm volatile("" : "+v"(lane));
    for (int w = F.vcu; w < 256; w += F.G) {
        const int b = w >> 6, j = w & 63;
#pragma unroll 1
        for (int k = 0; k < 4; ++k) { const int u = (k == 0) ? j : (k == 1) ? 127 - j : (k == 2) ? 128 + j : 255 - j; dsa_unit(F, lane, F.wave, b, u); }
    }
    __syncthreads();
}

struct Args { const void* in[16]; float* out; unsigned char* ws; };
__global__ void __launch_bounds__(NWAVES * 64, 2) fwd_kernel(Args args) {
    extern __shared__ __attribute__((aligned(16))) unsigned char lds[];
    Frame F;
    F.lds = (LAS unsigned char*)lds;
    F.MISC = (volatile LAS unsigned*)(F.lds + MISC_OFF);
    F.tid = threadIdx.x; F.lane = F.tid & 63; F.wave = __builtin_amdgcn_readfirstlane(F.tid >> 6);
    F.G = gridDim.x; { const int bx = blockIdx.x; F.vcu = (F.G % 8 == 0) ? (bx % 8) * (F.G / 8) + bx / 8 : bx; }
    unsigned char* ws = args.ws;
    F.ctl = (gu32*)(ws + WS_CTL);
    F.x = (const float*)args.in[0]; F.c = (const float*)args.in[1]; F.positions = (const int*)args.in[2]; F.w_ada = (const float*)args.in[3]; F.b_ada = (const float*)args.in[4];
    F.g_mix = (const float*)args.in[5]; F.w_in = (const float*)args.in[6]; F.conv_w = (const float*)args.in[7]; F.conv_b = (const float*)args.in[8]; F.conv_ng = (const float*)args.in[9];
    F.conv_nb = (const float*)args.in[10]; F.w_out = (const float*)args.in[11]; F.g_mlp = (const float*)args.in[12]; F.w_up = (const float*)args.in[13]; F.w_down = (const float*)args.in[14];
    F.g_final = (const float*)args.in[15]; F.out = args.out;
    F.Win_t = (bf16*)(ws + WS_WIN); F.Wout_t = (bf16*)(ws + WS_WOUT); F.Wup_t = (bf16*)(ws + WS_WUP); F.Wdn_t = (bf16*)(ws + WS_WDN);
    F.mod = (float*)(ws + WS_MOD); F.BIAS2 = (float*)(ws + WS_BIAS2); F.PART = (float*)(ws + WS_PART); F.CS = (float*)(ws + WS_CS); F.WI = (float*)(ws + WS_WI);
    F.H = (bf16*)(ws + WS_H); F.PROJ = (bf16*)(ws + WS_PROJ); F.Q = (bf16*)(ws + WS_Q); F.K = (bf16*)(ws + WS_K); F.V = (bf16*)(ws + WS_V); F.QI = (bf16*)(ws + WS_QI);
    F.KI = (bf16*)(ws + WS_KI); F.GLU = (bf16*)(ws + WS_GLU); F.MIX = (bf16*)(ws + WS_MIX); F.U = (bf16*)(ws + WS_U); F.SEL = (unsigned short*)(ws + WS_SEL); F.NSEL = (int*)(ws + WS_NSEL);
    for (int u = F.tid; u < (LDS_BYTES - LDSCTL_OFF) / 4; u += NWAVES * 64) ((LAS unsigned*)(F.lds + LDSCTL_OFF))[u] = 0u;
    __syncthreads();
    XcdBarrier bar = xcd_barrier_post((unsigned*)(F.ctl + CW_BAR), F.MISC + 8);
#define GRID_BAR() xcd_barrier(bar)
    const float* sh1 = F.mod, *sc1 = F.mod + D, *gt1 = F.mod + 2 * D, *sh2 = F.mod + 3 * D, *sc2 = F.mod + 4 * D, *gt2 = F.mod + 5 * D;

    p0_prologue(F); GRID_BAR();
    normmod_rows(F, F.x, F.g_mix, sh1, sc1, F.H); bias2_gemv(F, sh2); GRID_BAR();
    { pg8::Gemm g{F.H, F.Win_t, M, DINP, D}; pg8::StaticOrder So; So.init(M, DINP, F.G, (int)blockIdx.x);
      pg8::EpiProj E{F.Q, F.K, F.V, F.QI, F.KI, F.GLU, F.WI, F.CS, WI_SCALE};
      pg8::gemm_phase<pg8::EpiProj, pg8::StaticOrder, true, true>(F.lds + RING_OFF, g, So, E); }
    GRID_BAR();
    p4_conv(F); p4_dsa(F); GRID_BAR();
    p4_att(F); GRID_BAR();
    { pg8::Gemm g{F.MIX, F.Wout_t, M, D, D}; pg8::StaticOrder So; So.init(M, D, F.G, (int)blockIdx.x);
      pg8::EpiResGateA2 E{F.x, F.out, D, gt1, sc2, F.g_mlp, MODW, S, F.H, F.PART};
      pg8::gemm_phase<pg8::EpiResGateA2, pg8::StaticOrder, true, true>(F.lds + RING_OFF, g, So, E); }
    GRID_BAR();
    { pg8::Gemm g{F.H, F.Wup_t, M, FF, D}; pg8::StaticOrder So; So.init(M, FF, F.G, (int)blockIdx.x);
      pg8::EpiUp E{F.U, FF, F.BIAS2, FF, S, F.PART, 1.0f / D, EPS};
      pg8::gemm_phase<pg8::EpiUp, pg8::StaticOrder, true, true>(F.lds + RING_OFF, g, So, E); }
    GRID_BAR();
    { pg8::Gemm g{F.U, F.Wdn_t, M, D, FF}; pg8::StaticOrder So; So.init(M, D, F.G, (int)blockIdx.x);
      pg8::EpiResGate E{F.out, F.out, D, gt2, MODW, S};
      pg8::gemm_phase<pg8::EpiResGate, pg8::StaticOrder, true, true>(F.lds + RING_OFF, g, So, E); }
    GRID_BAR();
    final_norm_rows(F, F.out, F.g_final);
#undef GRID_BAR
}

extern "C" void kernel_launch(void* const* d_in, const int* in_sizes, int n_in, void* d_out, int out_size, void* d_ws, size_t ws_size, hipStream_t stream) {
    static int grid = 0;
    if (grid == 0) {
        if (n_in != 16 || in_sizes[0] != M * D || out_size != M * D || ws_size < WS_END) { fprintf(stderr, "kernel_launch: unexpected shapes (n_in %d, in0 %d, out %d, ws %zu); nothing launched\n", n_in, n_in > 0 ? in_sizes[0] : -1, out_size, ws_size); grid = -1; return; }
        int dev = 0, cus = 0, per_cu = 0;
        if (hipGetDevice(&dev) != hipSuccess || hipDeviceGetAttribute(&cus, hipDeviceAttributeMultiprocessorCount, dev) != hipSuccess) { grid = -1; return; }
        if (hipFuncSetAttribute((const void*)fwd_kernel, hipFuncAttributeMaxDynamicSharedMemorySize, LDS_BYTES) != hipSuccess) { fprintf(stderr, "kernel_launch: hipFuncSetAttribute failed\n"); grid = -1; return; }
        if (hipOccupancyMaxActiveBlocksPerMultiprocessor(&per_cu, (const void*)fwd_kernel, NWAVES * 64, LDS_BYTES) != hipSuccess || per_cu < 1) { fprintf(stderr, "kernel_launch: occupancy query says %d blocks per CU; nothing launched\n", per_cu); (void)hipGetLastError(); grid = -1; return; }
        grid = cus;
    }
    if (grid < 0) return;
    if (hipMemsetAsync((char*)d_ws + WS_CTL, 0, CTL_ZERO_BYTES, stream) != hipSuccess) { fprintf(stderr, "kernel_launch: memset failed\n"); return; }
    Args a{};
    for (int i = 0; i < 16; ++i) a.in[i] = d_in[i];
    a.out = (float*)d_out; a.ws = (unsigned char*)d_ws;
    hipLaunchKernelGGL(fwd_kernel, dim3(grid), dim3(NWAVES * 64), LDS_BYTES, stream, a);
}
```
